# Optimizing an MI355X kernel written in HIP

```python
import jax, jax.numpy as jnp
from jax import lax
import numpy as np

D_MODEL = 1024
BATCH = 8
SEQ = 2048
DEPTH = 2

N_HEADS = 16
HEAD_DIM = D_MODEL // N_HEADS
Q_BLOCK = 128
N_A_LAYERS = DEPTH // 2
N_B_LAYERS = DEPTH - N_A_LAYERS
N_GROUPS = 4
EXPERTS_PER_GROUP = 4
N_EXPERTS = N_GROUPS * EXPERTS_PER_GROUP
TOP_K_IN_GROUP = 2
D_EXPERT = D_MODEL // 2
RMS_EPS = 1e-6

kernel_name = "yoco_stickbreak_fox_hmoe"


def rms_norm(x, g):
    x32 = x.astype(jnp.float32)
    y = x32 * lax.rsqrt(jnp.mean(x32 * x32, axis=-1, keepdims=True) + RMS_EPS)
    return (y * g.astype(jnp.float32)).astype(x.dtype)


def split_heads(t):
    b, s, _ = t.shape
    return t.reshape(b, s, N_HEADS, HEAD_DIM).transpose(0, 2, 1, 3)


def merge_heads(t):
    b, h, s, dh = t.shape
    return t.transpose(0, 2, 1, 3).reshape(b, s, h * dh)


def stick_breaking_attention(q, k, v):
    seq = q.shape[2]
    scale = HEAD_DIM ** -0.5
    outs = []
    for i in range(seq // Q_BLOCK):
        q0 = i * Q_BLOCK
        kv_len = q0 + Q_BLOCK
        qb = q[:, :, q0:kv_len].astype(jnp.float32)
        kb = k[:, :, :kv_len].astype(jnp.float32)
        vb = v[:, :, :kv_len].astype(jnp.float32)
        z = jnp.einsum('bhqd,bhkd->bhqk', qb, kb) * scale
        t_pos = q0 + jnp.arange(Q_BLOCK)[:, None]
        s_pos = jnp.arange(kv_len)[None, :]
        strict = s_pos < t_pos
        log_keep = jnp.where(strict, jax.nn.log_sigmoid(-z), 0.0)
        log_after = lax.cumsum(log_keep, axis=3, reverse=True) - log_keep
        w = jnp.where(strict, jnp.exp(jax.nn.log_sigmoid(z) + log_after), 0.0)
        outs.append(jnp.einsum('bhqk,bhkd->bhqd', w, vb))
    return jnp.concatenate(outs, axis=2).astype(q.dtype)


def forgetting_attention(q, k, v, cum_logf):
    seq = q.shape[2]
    scale = HEAD_DIM ** -0.5
    outs = []
    for i in range(seq // Q_BLOCK):
        q0 = i * Q_BLOCK
        kv_len = q0 + Q_BLOCK
        qb = q[:, :, q0:kv_len].astype(jnp.float32)
        kb = k[:, :, :kv_len].astype(jnp.float32)
        vb = v[:, :, :kv_len].astype(jnp.float32)
        logits = (jnp.einsum('bhqd,bhkd->bhqk', qb, kb) * scale
                  + cum_logf[:, :, q0:kv_len, None] - cum_logf[:, :, None, :kv_len])
        t_pos = q0 + jnp.arange(Q_BLOCK)[:, None]
        s_pos = jnp.arange(kv_len)[None, :]
        probs = jax.nn.softmax(jnp.where(s_pos <= t_pos, logits, -jnp.inf), axis=-1)
        outs.append(jnp.einsum('bhqk,bhkd->bhqd', probs, vb))
    return jnp.concatenate(outs, axis=2).astype(q.dtype)


def hierarchical_moe(x, w_group, w_router, w_gate, w_up, w_down):
    b, s, d = x.shape
    xt = x.reshape(b * s, d)
    group_probs = jax.nn.softmax((xt @ w_group).astype(jnp.float32), axis=-1)
    g_prob, g_idx = lax.top_k(group_probs, 1)
    expert_logits = (xt @ w_router).astype(jnp.float32).reshape(-1, N_GROUPS, EXPERTS_PER_GROUP)
    in_group = jnp.take_along_axis(expert_logits, g_idx[:, :, None], axis=1)[:, 0]
    top_logits, e_idx = lax.top_k(in_group, TOP_K_IN_GROUP)
    e_w = jax.nn.softmax(top_logits, axis=-1) * g_prob
    expert_id = g_idx * EXPERTS_PER_GROUP + e_idx
    combine = jnp.sum(jax.nn.one_hot(expert_id, N_EXPERTS, dtype=jnp.float32) * e_w[..., None], axis=1)
    h = jax.nn.silu(jnp.einsum('nd,edf->nef', xt, w_gate)) * jnp.einsum('nd,edf->nef', xt, w_up)
    h = h * combine[:, :, None].astype(h.dtype)
    y = jnp.einsum('nef,efd->nd', h, w_down)
    return y.reshape(b, s, d).astype(x.dtype)


def setup_inputs(seed: int = 0) -> dict:
    key = jax.random.key(seed)
    ks = jax.random.split(key, 20)
    d, h, f = D_MODEL, N_HEADS, D_EXPERT
    sd = d ** -0.5
    nrm = jax.random.normal
    return {
        "x": nrm(ks[0], (BATCH, SEQ, d), jnp.float32),
        "attn_norm": 1.0 + 0.02 * nrm(ks[1], (DEPTH, d), jnp.float32),
        "w_qkv_a": nrm(ks[2], (N_A_LAYERS, d, 3 * d), jnp.float32) * sd,
        "w_o_a": nrm(ks[3], (N_A_LAYERS, d, d), jnp.float32) * sd,
        "kv_norm": 1.0 + 0.02 * nrm(ks[4], (d,), jnp.float32),
        "w_kvf": nrm(ks[5], (d, 2 * d + h), jnp.float32) * sd,
        "b_f": jax.random.uniform(ks[6], (h,), jnp.float32, 1.0, 4.0),
        "w_q_b": nrm(ks[7], (N_B_LAYERS, d, d), jnp.float32) * sd,
        "w_o_b": nrm(ks[8], (N_B_LAYERS, d, d), jnp.float32) * sd,
        "moe_norm": 1.0 + 0.02 * nrm(ks[9], (DEPTH, d), jnp.float32),
        "w_group": nrm(ks[10], (DEPTH, d, N_GROUPS), jnp.float32) * sd,
        "w_router": nrm(ks[11], (DEPTH, d, N_EXPERTS), jnp.float32) * sd,
        "w_gate": nrm(ks[12], (DEPTH, N_EXPERTS, d, f), jnp.float32) * sd,
        "w_up": nrm(ks[13], (DEPTH, N_EXPERTS, d, f), jnp.float32) * sd,
        "w_down": nrm(ks[14], (DEPTH, N_EXPERTS, f, d), jnp.float32) * (f ** -0.5),
        "final_norm": 1.0 + 0.02 * nrm(ks[15], (d,), jnp.float32),
    }


def reference(x, attn_norm, w_qkv_a, w_o_a, kv_norm, w_kvf, b_f, w_q_b, w_o_b,
              moe_norm, w_group, w_router, w_gate, w_up, w_down, final_norm):
    d = D_MODEL
    h = x
    k_shared = v_shared = cum_logf = None
    for layer in range(DEPTH):
        if layer < N_A_LAYERS:
            hn = rms_norm(h, attn_norm[layer])
            q, k, v = jnp.split(hn @ w_qkv_a[layer], 3, axis=-1)
            mix = stick_breaking_attention(split_heads(q), split_heads(k), split_heads(v))
            h = h + merge_heads(mix) @ w_o_a[layer]
        else:
            j = layer - N_A_LAYERS
            if j == 0:
                u = rms_norm(h, kv_norm)
                kvf = u @ w_kvf
                k_shared = split_heads(kvf[..., :d])
                v_shared = split_heads(kvf[..., d:2 * d])
                log_f = jax.nn.log_sigmoid((kvf[..., 2 * d:] + b_f).astype(jnp.float32))
                cum_logf = lax.cumsum(log_f, axis=1).transpose(0, 2, 1)
            hn = rms_norm(h, attn_norm[layer])
            q = split_heads(hn @ w_q_b[j])
            mix = forgetting_attention(q, k_shared, v_shared, cum_logf)
            h = h + merge_heads(mix) @ w_o_b[j]
        h = h + hierarchical_moe(rms_norm(h, moe_norm[layer]), w_group[layer], w_router[layer],
                                 w_gate[layer], w_up[layer], w_down[layer])
    return rms_norm(h, final_norm)
```

```cpp
#include <hip/hip_runtime.h>
#include <cstdio>
#include <cstdint>
namespace pg8 {
#define PG8_LAS __attribute__((address_space(3)))
typedef unsigned short bf16_t;
typedef short bf16x8 __attribute__((ext_vector_type(8)));
typedef float f32x4 __attribute__((ext_vector_type(4)));
typedef unsigned u32x4 __attribute__((ext_vector_type(4)));
constexpr int BM = 256, BK = 64, HALF = 128, HTB = HALF * BK * 2  , STAGE_BYTES = 8 * HTB, NXCD = 8, WGM = 8;

__host__ __device__ __forceinline__ int lds_byte(int r, int c) { const int st = (r >> 4) * 2 + (c >> 5), rr = r & 15, cc = c & 31, ob = rr * 64 + cc * 2; return st * 1024 + (ob ^ (((ob >> 9) & 1) << 5)); }
__host__ __device__ __forceinline__ void stage_rc(int b, int& R, int& C) { const int st = b / 1024, sb = b % 1024, swz = sb ^ (((sb >> 9) & 1) << 5); R = (st >> 1) * 16 + swz / 64; C = (st & 1) * 32 + (swz % 64) / 2; }
__host__ __device__ __forceinline__ int perm32(int rho) { const int n = rho >> 4, i = rho & 15; return 8 * (i >> 2) + 4 * n + (i & 3); }

struct Unit { int pm, pn, pb; };
struct Gemm { const bf16_t* A; const bf16_t* Bt; int M, N, K; };
struct StaticOrder {
    int nM, nN, nwg, G, c;
    __host__ __device__ void init(int M, int N, int G_, int c_) { nM = M / BM; nN = N / BM; nwg = nM * nN; G = G_; c = c_; }
    __host__ __device__ bool next(int i, Unit& u) const {
        const long L = (long)i * G + c; if (L >= nwg) return false;
        int wgid = (int)L; { const int q = nwg / NXCD, r = nwg % NXCD, xcd = wgid % NXCD, off = wgid / NXCD; wgid = (xcd < r ? xcd * (q + 1) : r * (q + 1) + (xcd - r) * q) + off; }
        const int nig = WGM * nN, gid = wgid / nig, fm = gid * WGM, gsz = (nM - fm) < WGM ? (nM - fm) : WGM;
        u.pm = fm + ((wgid % nig) % gsz); u.pn = (wgid % nig) / gsz; u.pb = u.pn; return true;
    }
    __device__ __forceinline__ void a_ready(const Unit&) const {}
    __device__ __forceinline__ void done(const Unit&) const {}
};
struct MoeOrder {
    const PG8_LAS int* pt; int nwg, G, c;
    __device__ bool next(int i, Unit& u) const {
        const long L = (long)i * G + c; if (L >= nwg) return false;
        int wgid = (int)L; { const int q = nwg / NXCD, r = nwg % NXCD, xcd = wgid % NXCD, off = wgid / NXCD; wgid = (xcd < r ? xcd * (q + 1) : r * (q + 1) + (xcd - r) * q) + off; }
        const int rt = wgid >> 2, j = wgid & 3; int e = 0;
#pragma unroll
        for (int k = 1; k < 16; ++k) e += (pt[k] <= rt) ? 1 : 0;
        u.pm = rt; u.pn = j; u.pb = e * 4 + j; return true;
    }
    __device__ __forceinline__ void a_ready(const Unit&) const {}
    __device__ __forceinline__ void done(const Unit&) const {}
};

__device__ __forceinline__ unsigned cvt_pk_bf16(float lo, float hi) { unsigned r; asm volatile("v_cvt_pk_bf16_f32 %0, %1, %2" : "=v"(r) : "v"(lo), "v"(hi)); return r; }
struct EpiSplit3 {
    static constexpr bool PERM = true, AFTER_DRAIN = false;
    bf16_t* O0; size_t ostride; int rot; const float* rstd; int qsel; float qscale;
    __device__ __forceinline__ void operator()(const f32x4 (&acc)[2][2][4][2], const Unit& u, int wr, int wc, int fr, int fq) const {
        const int row0 = u.pm * BM + wr * 64 + fr; int colt = u.pn * BM; const int t = colt >> 10; colt &= 1023;
        int tb = t + rot; tb = tb >= 3 ? tb - 3 : tb; bf16_t* base = O0 + (size_t)tb * ostride; const float sc = (t == qsel) ? qscale : 1.f;
        const int col0 = colt + wc * 32 + 8 * fq;
#pragma unroll
        for (int ai = 0; ai < 2; ++ai)
#pragma unroll
            for (int m = 0; m < 4; ++m) { const int row = row0 + ai * HALF + m * 16; const float rs = rstd[row] * sc; bf16_t* rowp = base + (size_t)row * 1024 + col0;
#pragma unroll
                for (int bj = 0; bj < 2; ++bj) { const f32x4 v0 = acc[ai][bj][m][0] * rs, v1 = acc[ai][bj][m][1] * rs;
                    u32x4 w; w.x = cvt_pk_bf16(v0[0], v0[1]); w.y = cvt_pk_bf16(v0[2], v0[3]); w.z = cvt_pk_bf16(v1[0], v1[1]); w.w = cvt_pk_bf16(v1[2], v1[3]);
                    *(u32x4*)(rowp + bj * HALF) = w; } }
    }
};
struct EpiResid {
    static constexpr bool PERM = false, AFTER_DRAIN = false;
    const float* base; float* out; int ldc;
    __device__ __forceinline__ void operator()(const f32x4 (&acc)[2][2][4][2], const Unit& u, int wr, int wc, int fr, int fq) const {
        const int row0 = u.pm * BM + wr * 64 + fr, col0 = u.pn * BM + wc * 32 + 4 * fq;
#pragma unroll
        for (int ai = 0; ai < 2; ++ai)
#pragma unroll
            for (int m = 0; m < 4; ++m) { const size_t off = (size_t)(row0 + ai * HALF + m * 16) * ldc + col0;
#pragma unroll
                for (int bj = 0; bj < 2; ++bj)
#pragma unroll
                    for (int n = 0; n < 2; ++n) { const f32x4 bs = *(const f32x4*)(base + off + bj * HALF + n * 16); *(f32x4*)(out + off + bj * HALF + n * 16) = bs + acc[ai][bj][m][n]; } }
    }
};
struct EpiGateUp {
    static constexpr bool PERM = true, AFTER_DRAIN = false;
    bf16_t* H;
    __device__ __forceinline__ void operator()(const f32x4 (&acc)[2][2][4][2], const Unit& u, int wr, int wc, int fr, int fq) const {
        const int row0 = u.pm * BM + wr * 64 + fr, col0 = u.pn * HALF + wc * 32 + 8 * fq;
#pragma unroll
        for (int ai = 0; ai < 2; ++ai)
#pragma unroll
            for (int m = 0; m < 4; ++m) { bf16_t* rowp = H + (size_t)(row0 + ai * HALF + m * 16) * 512 + col0; float hv[8];
#pragma unroll
                for (int n = 0; n < 2; ++n)
#pragma unroll
                    for (int j = 0; j < 4; ++j) { const float g = acc[ai][0][m][n][j], up = acc[ai][1][m][n][j];
                        hv[n * 4 + j] = g * __builtin_amdgcn_rcpf(1.f + __builtin_amdgcn_exp2f(-1.4426950408889634f * g)) * up; }
                u32x4 w; w.x = cvt_pk_bf16(hv[0], hv[1]); w.y = cvt_pk_bf16(hv[2], hv[3]); w.z = cvt_pk_bf16(hv[4], hv[5]); w.w = cvt_pk_bf16(hv[6], hv[7]);
                *(u32x4*)rowp = w; }
    }
};
struct EpiBf16Plain {
    static constexpr bool PERM = true, AFTER_DRAIN = false;
    bf16_t* O; int ldc;
    __device__ __forceinline__ void operator()(const f32x4 (&acc)[2][2][4][2], const Unit& u, int wr, int wc, int fr, int fq) const {
        const int row0 = u.pm * BM + wr * 64 + fr, col0 = u.pn * BM + wc * 32 + 8 * fq;
#pragma unroll
        for (int ai = 0; ai < 2; ++ai)
#pragma unroll
            for (int m = 0; m < 4; ++m) { bf16_t* rowp = O + (size_t)(row0 + ai * HALF + m * 16) * ldc + col0;
#pragma unroll
                for (int bj = 0; bj < 2; ++bj) { const f32x4 v0 = acc[ai][bj][m][0], v1 = acc[ai][bj][m][1];
                    u32x4 w; w.x = cvt_pk_bf16(v0[0], v0[1]); w.y = cvt_pk_bf16(v0[2], v0[3]); w.z = cvt_pk_bf16(v1[0], v1[1]); w.w = cvt_pk_bf16(v1[2], v1[3]);
                    *(u32x4*)(rowp + bj * HALF) = w; } }
    }
};

template <class Epi, class Sched, bool ALIGN_EPI = false, bool SP2 = false>
__device__ __forceinline__ void gemm_phase(PG8_LAS unsigned char* lds, const Gemm g, const Sched& S, const Epi& E) {
    const int tid = threadIdx.x, wid = __builtin_amdgcn_readfirstlane(tid >> 6), lane = tid & 63, wr = wid >> 2, wc = wid & 3, fr = lane & 15, fq = lane >> 4;
    const int K = g.K, nt = K / BK;
    unsigned voffA[2], voffB[2];
#pragma unroll
    for (int i = 0; i < 2; ++i) { int R, C; stage_rc(tid * 16 + i * 8192, R, C); const int Rb = Epi::PERM ? ((R & ~31) + perm32(R & 31)) : R;
        voffA[i] = (unsigned)(R * K + C) * 2u; voffB[i] = (unsigned)(Rb * K + C) * 2u; }
    const size_t kstep = (size_t)(BK * 2);
    const size_t hstep = (size_t)HALF * K * 2;
    const size_t tstep = 2 * hstep;
    const unsigned ldsw = (unsigned)wid * 1024u;
    const int aoff = lds_byte(wr * 64 + fr, fq * 8), boff = lds_byte(wc * 32 + fr, fq * 8);
#define PG8_SA(b, h) (((b) * 2 + (h)) * HTB)
#define PG8_SB(b, h) ((4 + (b) * 2 + (h)) * HTB)
#define PG8_STAGE(bufoff, gbase, voff) do { _Pragma("unroll") for (int _i = 0; _i < 2; ++_i) \
        __builtin_amdgcn_global_load_lds((const unsigned*)((const char*)(gbase) + (voff)[_i]), (PG8_LAS unsigned*)(lds + (bufoff) + ldsw + _i * 8192), 16, 0, 0); } while (0)
#define PG8_LDA(dst, b, h) do { _Pragma("unroll") for (int m = 0; m < 4; ++m) _Pragma("unroll") for (int k = 0; k < 2; ++k) dst[m][k] = *(const PG8_LAS bf16x8*)(lds + PG8_SA(b, h) + aoff + m * 2048 + k * 1024); } while (0)
#define PG8_LDB(dst, b, h) do { _Pragma("unroll") for (int n = 0; n < 2; ++n) _Pragma("unroll") for (int k = 0; k < 2; ++k) dst[n][k] = *(const PG8_LAS bf16x8*)(lds + PG8_SB(b, h) + boff + n * 2048 + k * 1024); } while (0)
#define PG8_MMA(ai, bj, At, Bt) do { __builtin_amdgcn_s_setprio(1); _Pragma("unroll") for (int m = 0; m < 4; ++m) _Pragma("unroll") for (int n = 0; n < 2; ++n) _Pragma("unroll") for (int k = 0; k < 2; ++k) \
        acc[ai][bj][m][n] = __builtin_amdgcn_mfma_f32_16x16x32_bf16(Bt[n][k], At[m][k], acc[ai][bj][m][n], 0, 0, 0); __builtin_amdgcn_s_setprio(0); } while (0)
#define PG8_WAIT_V(n) asm volatile("s_waitcnt vmcnt(" #n ")" ::: "memory")
#define PG8_WAIT_L(n) asm volatile("s_waitcnt lgkmcnt(" #n ")" ::: "memory")
#define PG8_BAR __builtin_amdgcn_s_barrier()
#define PG8_SCHED __builtin_amdgcn_sched_barrier(0)
    Unit cur, nxt; int ui = 0;
    if (!S.next(0, cur)) return;
    f32x4 acc[2][2][4][2];
#pragma unroll
    for (int a = 0; a < 2; ++a)
#pragma unroll
        for (int b = 0; b < 2; ++b)
#pragma unroll
            for (int m = 0; m < 4; ++m)
#pragma unroll
                for (int n = 0; n < 2; ++n) acc[a][b][m][n] = (f32x4){0.f, 0.f, 0.f, 0.f};
    bf16x8 At[4][2], B0[2][2], B1[2][2];
    const char* cA = (const char*)g.A + (size_t)cur.pm * tstep; const char* cB = (const char*)g.Bt + (size_t)cur.pb * tstep;
    S.a_ready(cur);
    if constexpr (SP2) {
        PG8_STAGE(PG8_SB(0, 0), cB, voffB); PG8_STAGE(PG8_SB(0, 1), cB + hstep, voffB); PG8_STAGE(PG8_SA(0, 0), cA, voffA); PG8_STAGE(PG8_SA(0, 1), cA + hstep, voffA);
        if (wr == 1) PG8_BAR;
        PG8_WAIT_V(2); PG8_BAR;
        PG8_STAGE(PG8_SB(1, 0), cB + kstep, voffB); PG8_STAGE(PG8_SA(1, 0), cA + kstep, voffA); PG8_STAGE(PG8_SB(1, 1), cB + hstep + kstep, voffB);
        PG8_WAIT_V(6); PG8_BAR;
    } else {
        PG8_STAGE(PG8_SB(0, 0), cB, voffB); PG8_STAGE(PG8_SA(0, 0), cA, voffA); PG8_STAGE(PG8_SB(0, 1), cB + hstep, voffB); PG8_STAGE(PG8_SA(0, 1), cA + hstep, voffA);
        if (wr == 1) PG8_BAR;
        PG8_WAIT_V(4); PG8_BAR;
        PG8_STAGE(PG8_SB(1, 0), cB + kstep, voffB); PG8_STAGE(PG8_SA(1, 0), cA + kstep, voffA); PG8_STAGE(PG8_SB(1, 1), cB + hstep + kstep, voffB);
        PG8_WAIT_V(6); PG8_BAR;
    }
    for (;;) {
        const bool has_next = S.next(ui + 1, nxt);
        const char* nA = has_next ? (const char*)g.A + (size_t)nxt.pm * tstep : cA; const char* nB = has_next ? (const char*)g.Bt + (size_t)nxt.pb * tstep : cB;
        for (int t = 0; t < nt; t += 2) {
            const bool last = (t == nt - 2);
            const char* a1 = cA + (size_t)(t + 1) * kstep;
            const char* a2 = last ? nA : cA + (size_t)(t + 2) * kstep; const char* b2 = last ? nB : cB + (size_t)(t + 2) * kstep;
            const char* a3 = a2 + kstep; const char* b3 = b2 + kstep;
            if (last && has_next) S.a_ready(nxt);
            if constexpr (SP2) {
            PG8_LDB(B0, 0, 0); PG8_LDB(B1, 0, 1); PG8_SCHED; PG8_LDA(At, 0, 0); PG8_STAGE(PG8_SA(1, 1), a1 + hstep, voffA);
            PG8_WAIT_V(8); PG8_WAIT_L(0); PG8_BAR; PG8_MMA(0, 0, At, B0); PG8_MMA(0, 1, At, B1); PG8_BAR; PG8_SCHED;
            PG8_LDA(At, 0, 1); PG8_STAGE(PG8_SB(0, 0), b2, voffB); PG8_STAGE(PG8_SB(0, 1), b2 + hstep, voffB); PG8_STAGE(PG8_SA(0, 0), a2, voffA);
            PG8_WAIT_V(8); PG8_WAIT_L(0); PG8_BAR; PG8_MMA(1, 0, At, B0); PG8_MMA(1, 1, At, B1); PG8_BAR; PG8_SCHED;
            PG8_LDB(B0, 1, 0); PG8_LDB(B1, 1, 1); PG8_SCHED; PG8_LDA(At, 1, 0); PG8_STAGE(PG8_SA(0, 1), a2 + hstep, voffA);
            PG8_WAIT_V(8); PG8_WAIT_L(0); PG8_BAR; PG8_MMA(0, 0, At, B0); PG8_MMA(0, 1, At, B1); PG8_BAR; PG8_SCHED;
            PG8_LDA(At, 1, 1); PG8_STAGE(PG8_SB(1, 0), b3, voffB); PG8_STAGE(PG8_SB(1, 1), b3 + hstep, voffB); PG8_STAGE(PG8_SA(1, 0), a3, voffA);
            PG8_WAIT_V(8); PG8_WAIT_L(0); PG8_BAR; PG8_MMA(1, 0, At, B0); PG8_MMA(1, 1, At, B1); PG8_BAR; PG8_SCHED;
            } else {
            PG8_LDB(B0, 0, 0); PG8_SCHED; PG8_LDA(At, 0, 0); PG8_STAGE(PG8_SA(1, 1), a1 + hstep, voffA);
            PG8_WAIT_L(8); PG8_BAR; PG8_WAIT_L(0); PG8_MMA(0, 0, At, B0); PG8_BAR; PG8_SCHED;
            PG8_LDB(B1, 0, 1); PG8_STAGE(PG8_SB(0, 0), b2, voffB);
            PG8_BAR; PG8_WAIT_L(0); PG8_MMA(0, 1, At, B1); PG8_BAR;
            PG8_LDA(At, 0, 1); PG8_STAGE(PG8_SA(0, 0), a2, voffA);
            PG8_BAR; PG8_WAIT_L(0); PG8_MMA(1, 0, At, B0); PG8_BAR; PG8_SCHED;
            PG8_STAGE(PG8_SB(0, 1), b2 + hstep, voffB);
            PG8_WAIT_V(6); PG8_BAR; PG8_MMA(1, 1, At, B1); PG8_BAR;
            PG8_LDB(B0, 1, 0); PG8_SCHED; PG8_LDA(At, 1, 0); PG8_STAGE(PG8_SA(0, 1), a2 + hstep, voffA);
            PG8_WAIT_L(8); PG8_BAR; PG8_WAIT_L(0); PG8_MMA(0, 0, At, B0); PG8_BAR; PG8_SCHED;
            PG8_LDB(B1, 1, 1); PG8_STAGE(PG8_SB(1, 0), b3, voffB);
            PG8_BAR; PG8_WAIT_L(0); PG8_MMA(0, 1, At, B1); PG8_BAR;
            PG8_LDA(At, 1, 1); PG8_STAGE(PG8_SA(1, 0), a3, voffA);
            PG8_BAR; PG8_WAIT_L(0); PG8_MMA(1, 0, At, B0); PG8_BAR; PG8_SCHED;
            PG8_STAGE(PG8_SB(1, 1), b3 + hstep, voffB);
            PG8_WAIT_V(6); PG8_BAR; PG8_MMA(1, 1, At, B1); PG8_BAR;
            }
        }
        if constexpr (ALIGN_EPI) { if (wr == 0) PG8_BAR; }
        if constexpr (!Epi::AFTER_DRAIN) { E(acc, cur, wr, wc, fr, fq); S.done(cur); }
        if (!has_next) break;
#pragma unroll
        for (int a = 0; a < 2; ++a)
#pragma unroll
            for (int b = 0; b < 2; ++b)
#pragma unroll
                for (int m = 0; m < 4; ++m)
#pragma unroll
                    for (int n = 0; n < 2; ++n) acc[a][b][m][n] = (f32x4){0.f, 0.f, 0.f, 0.f};
        cur = nxt; cA = nA; cB = nB; ++ui;
        if constexpr (ALIGN_EPI) { if (wr == 1) PG8_BAR; }
    }
    PG8_WAIT_V(0);
    if constexpr (!ALIGN_EPI) { if (wr == 0) PG8_BAR; }
    PG8_BAR;
    if constexpr (Epi::AFTER_DRAIN) { E.fused(acc, cur, wr, wc, fr, fq, lds, wid, lane); S.done(cur); }
#undef PG8_SA
#undef PG8_SB
#undef PG8_STAGE
#undef PG8_LDA
#undef PG8_LDB
#undef PG8_MMA
#undef PG8_WAIT_V
#undef PG8_WAIT_L
#undef PG8_BAR
#undef PG8_SCHED
}
}
namespace att {
typedef unsigned short bf16;
typedef short bf16x8 __attribute__((ext_vector_type(8)));
typedef short s16x4 __attribute__((ext_vector_type(4)));
typedef float f32x16 __attribute__((ext_vector_type(16)));
typedef float f32x4 __attribute__((ext_vector_type(4)));
typedef unsigned u32x4 __attribute__((ext_vector_type(4)));
typedef unsigned u32x2 __attribute__((ext_vector_type(2)));
#define ALAS __attribute__((address_space(3)))
constexpr int SEQ = 2048, NH = 16, DM = 1024, QB = 256, KVB = 64;
constexpr int SLOTB = 8192, L_K = 0, L_V = 2 * SLOTB, L_CB = 4 * SLOTB, L_WT = L_CB + SEQ * 4, L_ST = L_WT + 256, STG_ROW = 144, LDS_BYTES = L_ST + 8 * 32 * STG_ROW;
constexpr float C2 = 0.125f * 1.4426950408889634f;
__device__ __forceinline__ int crow(int r, int hi) { return (r & 3) + 8 * (r >> 2) + 4 * hi; }
__device__ __forceinline__ void glds16(const void* gsrc, unsigned lds_dst) { unsigned keep;
    asm volatile("s_mov_b32 %0, m0\n\ts_mov_b32 m0, %2\n\ts_nop 0\n\tglobal_load_lds_dwordx4 %1, off\n\ts_mov_b32 m0, %0" : "=&s"(keep) : "v"(gsrc), "s"(lds_dst) : "memory"); }
typedef float f32x2_t __attribute__((ext_vector_type(2))); typedef __bf16 bf16x2_t __attribute__((ext_vector_type(2)));
__device__ __forceinline__ unsigned cvtpk(float lo, float hi) { f32x2_t v = {lo, hi}; bf16x2_t b = __builtin_convertvector(v, bf16x2_t); return __builtin_bit_cast(unsigned, b); }
typedef short v4i16_t __attribute__((ext_vector_type(4)));
__device__ __forceinline__ s16x4 vtr(const ALAS char* p) { return __builtin_bit_cast(s16x4, __builtin_amdgcn_ds_read_tr16_b64_v4i16((ALAS v4i16_t*)p)); }
__device__ __forceinline__ float swap_other_mul(float x) { auto rr = __builtin_amdgcn_permlane32_swap(__float_as_uint(x), __float_as_uint(x), false, false); return __uint_as_float(rr[0]) * __uint_as_float(rr[1]); }

template <int MODE>
__device__ __forceinline__ void attn_unit(int b, int h, int qb, const bf16* Q, const bf16* K, const bf16* V, bf16* O, const float* logf, ALAS char* shm) {
    const int tid = threadIdx.x, lane = tid & 63, r32 = lane & 31, hi = lane >> 5; const int wid = __builtin_amdgcn_readfirstlane(tid >> 6);
    const long rowbase = (long)b * SEQ; const int q0 = qb * QB;
    const bf16* Qw = Q + (rowbase + q0 + wid * 32) * DM + h * 64;
    const bf16* Kh = K + rowbase * DM + h * 64; const bf16* Vh = V + rowbase * DM + h * 64;
    const unsigned lds0 = (unsigned)(size_t)shm;
    const bf16* ksrc = Kh + (long)lane * DM + wid * 8;
    const bf16* vsrc = Vh + (long)(16 * (wid & 3) + (lane >> 2)) * DM + (wid >> 2) * 32 + (lane & 3) * 8;
    const unsigned kdst = lds0 + L_K + wid * 1024, vdst = lds0 + L_V + wid * 1024;
#define DMA_KV(t, slot) do { glds16(ksrc + (long)(t) * KVB * DM, (unsigned)__builtin_amdgcn_readfirstlane(kdst + (slot) * SLOTB)); \
                             glds16(vsrc + (long)(t) * KVB * DM, (unsigned)__builtin_amdgcn_readfirstlane(vdst + (slot) * SLOTB)); } while (0)
    const int NT = (q0 + QB) / KVB;
    DMA_KV(NT - 1, 0);
    bf16x8 qr[4];
#pragma unroll
    for (int d0 = 0; d0 < 4; ++d0) qr[d0] = *reinterpret_cast<const bf16x8*>(&Qw[(long)r32 * DM + d0 * 16 + hi * 8]);
    ALAS float* cb = (ALAS float*)(shm + L_CB);
    float ct2 = 0.f;
    if (MODE == 1) {
        ALAS float* wt = (ALAS float*)(shm + L_WT);
        float v0 = logf[(rowbase + 4 * tid + 0) * NH + h], v1 = logf[(rowbase + 4 * tid + 1) * NH + h], v2 = logf[(rowbase + 4 * tid + 2) * NH + h], v3 = logf[(rowbase + 4 * tid + 3) * NH + h];
        v1 += v0; v2 += v1; v3 += v2; float x = v3;
#pragma unroll
        for (int off = 1; off < 64; off <<= 1) { const float n = __shfl_up(x, off); if (lane >= off) x += n; }
        if (lane == 63) wt[wid] = x;
        __syncthreads();
        float pre = x - v3;
        for (int w2 = 0; w2 < wid; ++w2) pre += wt[w2];
        const float L2E = 1.4426950408889634f;
        *(ALAS f32x4*)(cb + 4 * tid) = (f32x4){(pre + v0) * L2E, (pre + v1) * L2E, (pre + v2) * L2E, (pre + v3) * L2E};
        __syncthreads();
        ct2 = cb[q0 + wid * 32 + r32];
    }
    f32x16 o[2]; o[0] = f32x16{}; o[1] = f32x16{};
    float carry = 1.f, mrun = -1e30f, lrun = 0.f;
    const int trow = q0 + wid * 32 + r32;
    const ALAS char* kp0 = shm + L_K + hi * 1024 + r32 * 16;
    const ALAS char* vp0 = shm + L_V + ((lane >> 4) & 1) * 32 + (lane & 3) * 8 + (4 * hi + ((lane & 15) >> 2)) * 64;
    for (int it = 0; it < NT; ++it) {
        const int jt = NT - 1 - it, slot = it & 1, ks = jt * KVB;
        asm volatile("s_waitcnt vmcnt(0) lgkmcnt(0)\n\ts_barrier" ::: "memory");
        if (it + 1 < NT) DMA_KV(jt - 1, slot ^ 1);
        if (ks > q0 + wid * 32 + 31) continue;
        const bool band = (ks + 63 >= q0 + wid * 32);
        const ALAS char* kp = kp0 + slot * SLOTB; const ALAS char* vp = vp0 + slot * SLOTB;
        f32x16 p0, p1;
#pragma unroll
        for (int d0 = 0; d0 < 4; ++d0) {
            const bf16x8 k0 = *(const ALAS bf16x8*)(kp + d0 * 2048), k1 = *(const ALAS bf16x8*)(kp + d0 * 2048 + 512);
            if (d0 == 0) { p0 = __builtin_amdgcn_mfma_f32_32x32x16_bf16(k0, qr[0], f32x16{}, 0, 0, 0); p1 = __builtin_amdgcn_mfma_f32_32x32x16_bf16(k1, qr[0], f32x16{}, 0, 0, 0); }
            else { p0 = __builtin_amdgcn_mfma_f32_32x32x16_bf16(k0, qr[d0], p0, 0, 0, 0); p1 = __builtin_amdgcn_mfma_f32_32x32x16_bf16(k1, qr[d0], p1, 0, 0, 0); }
        }
        if (MODE == 0) {
            f32x16 n0, n1;
#pragma unroll
            for (int r = 0; r < 16; ++r) {
                { const float z = __builtin_fmaxf(p0[r], -100.f), e = __builtin_amdgcn_exp2f(-z), rr = __builtin_amdgcn_rcpf(1.f + e); p0[r] = rr; n0[r] = e * rr; }
                { const float z = __builtin_fmaxf(p1[r], -100.f), e = __builtin_amdgcn_exp2f(-z), rr = __builtin_amdgcn_rcpf(1.f + e); p1[r] = rr; n1[r] = e * rr; }
            }
            if (band) {
#pragma unroll
                for (int r = 0; r < 16; ++r) { const int kv = ks + crow(r, hi);
                    if (kv >= trow) { p0[r] = 0.f; n0[r] = 1.f; }
                    if (kv + 32 >= trow) { p1[r] = 0.f; n1[r] = 1.f; } }
            }
            float G[8], i2[8], i1[8], i0[8];
#pragma unroll
            for (int g = 0; g < 4; ++g) { i2[g] = n0[4 * g + 3]; i1[g] = i2[g] * n0[4 * g + 2]; i0[g] = i1[g] * n0[4 * g + 1]; G[g] = i0[g] * n0[4 * g];
                                          i2[4 + g] = n1[4 * g + 3]; i1[4 + g] = i2[4 + g] * n1[4 * g + 2]; i0[4 + g] = i1[4 + g] * n1[4 * g + 1]; G[4 + g] = i0[4 + g] * n1[4 * g]; }
            float run = carry;
#pragma unroll
            for (int g = 7; g >= 0; --g) {
                auto rr = __builtin_amdgcn_permlane32_swap(__float_as_uint(G[g]), __float_as_uint(G[g]), false, false);
                const float other = hi ? 1.f : __uint_as_float(rr[1]);
                const float T = __uint_as_float(rr[0]) * __uint_as_float(rr[1]);
                const float af = run * other; run *= T;
                if (g < 4) { p0[4 * g + 3] *= af; p0[4 * g + 2] *= af * i2[g]; p0[4 * g + 1] *= af * i1[g]; p0[4 * g] *= af * i0[g]; }
                else { const int gg = g - 4; p1[4 * gg + 3] *= af; p1[4 * gg + 2] *= af * i2[g]; p1[4 * gg + 1] *= af * i1[g]; p1[4 * gg] *= af * i0[g]; }
            }
            carry = run;
        } else {
#pragma unroll
            for (int g = 0; g < 4; ++g) { const f32x4 ca = *(const ALAS f32x4*)(cb + ks + 8 * g + 4 * hi), cc = *(const ALAS f32x4*)(cb + ks + 32 + 8 * g + 4 * hi);
#pragma unroll
                for (int j = 0; j < 4; ++j) { p0[4 * g + j] += ct2 - ca[j]; p1[4 * g + j] += ct2 - cc[j]; } }
            if (band) {
#pragma unroll
                for (int r = 0; r < 16; ++r) { const int kv = ks + crow(r, hi);
                    if (kv > trow) p0[r] = -INFINITY;
                    if (kv + 32 > trow) p1[r] = -INFINITY; }
            }
            float rm = __builtin_fmaxf(p0[0], p1[0]);
#pragma unroll
            for (int r = 1; r < 16; ++r) rm = __builtin_fmaxf(rm, __builtin_fmaxf(p0[r], p1[r]));
            { auto rr = __builtin_amdgcn_permlane32_swap(__float_as_uint(rm), __float_as_uint(rm), false, false); rm = __builtin_fmaxf(__uint_as_float(rr[0]), __uint_as_float(rr[1])); }
            if (__any(rm > mrun)) { const float mn = __builtin_fmaxf(mrun, rm), f = __builtin_amdgcn_exp2f(mrun - mn); mrun = mn; lrun *= f;
#pragma unroll
                for (int r = 0; r < 16; ++r) { o[0][r] *= f; o[1][r] *= f; } }
            float sacc = 0.f;
#pragma unroll
            for (int r = 0; r < 16; ++r) { p0[r] = __builtin_amdgcn_exp2f(p0[r] - mrun); p1[r] = __builtin_amdgcn_exp2f(p1[r] - mrun); sacc += p0[r] + p1[r]; }
            lrun += sacc;
        }
        u32x4 pw[4];
#pragma unroll
        for (int j = 0; j < 4; ++j) { pw[0][j] = cvtpk(p0[2 * j], p0[2 * j + 1]); pw[1][j] = cvtpk(p0[8 + 2 * j], p0[8 + 2 * j + 1]); pw[2][j] = cvtpk(p1[2 * j], p1[2 * j + 1]); pw[3][j] = cvtpk(p1[8 + 2 * j], p1[8 + 2 * j + 1]); }
#pragma unroll
        for (int d0 = 0; d0 < 2; ++d0)
#pragma unroll
            for (int kq = 0; kq < 4; ++kq) { const s16x4 lo = vtr(vp + d0 * 4096 + kq * 1024), hh = vtr(vp + d0 * 4096 + kq * 1024 + 512);
                const bf16x8 vf = (bf16x8){lo[0], lo[1], lo[2], lo[3], hh[0], hh[1], hh[2], hh[3]};
                o[d0] = __builtin_amdgcn_mfma_f32_32x32x16_bf16(vf, __builtin_bit_cast(bf16x8, pw[kq]), o[d0], 0, 0, 0); }
    }
#undef DMA_KV
    float inv = 1.f;
    if (MODE == 1) { auto rr = __builtin_amdgcn_permlane32_swap(__float_as_uint(lrun), __float_as_uint(lrun), false, false); inv = __builtin_amdgcn_rcpf(__uint_as_float(rr[0]) + __uint_as_float(rr[1])); }
    ALAS char* stg = shm + L_ST + wid * 32 * STG_ROW;
#pragma unroll
    for (int d0 = 0; d0 < 2; ++d0)
#pragma unroll
        for (int g = 0; g < 4; ++g) { u32x2 w; w.x = cvtpk(o[d0][4 * g] * inv, o[d0][4 * g + 1] * inv); w.y = cvtpk(o[d0][4 * g + 2] * inv, o[d0][4 * g + 3] * inv);
            *(ALAS u32x2*)(stg + r32 * STG_ROW + (32 * d0 + 8 * g + 4 * hi) * 2) = w; }
    asm volatile("s_waitcnt lgkmcnt(0)" ::: "memory");
    bf16* Ow = O + (rowbase + q0 + wid * 32) * DM + h * 64;
#pragma unroll
    for (int i = 0; i < 4; ++i) { const int row = i * 8 + (lane >> 3), ch = lane & 7; const u32x4 v = *(const ALAS u32x4*)(stg + row * STG_ROW + ch * 16); *(u32x4*)(Ow + (long)row * DM + ch * 8) = v; }
    asm volatile("s_waitcnt vmcnt(0) lgkmcnt(0)\n\ts_barrier" ::: "memory");
}
template <int MODE>
__device__ __forceinline__ void attn_phase(ALAS char* lds, int vcu, int G, const bf16* Q, const bf16* K, const bf16* V, bf16* O, const float* logf) {
    for (int v = vcu; v < 256; v += G) {
        const int bh = v >> 1, s = v & 1;
#pragma unroll 1
        for (int i = 0; i < 4; ++i) { const int qb = s ? (i == 0 ? 2 : i == 1 ? 5 : i == 2 ? 3 : 4) : (i == 0 ? 0 : i == 1 ? 7 : i == 2 ? 1 : 6);
            attn_unit<MODE>(bh / NH, bh % NH, qb, Q, K, V, O, logf, lds); }
    }
}
}
constexpr int NWAVES = 8;
constexpr int BATCH = 8, SEQ = 2048, D = 1024, NH = 16, NE = 16, FE = 512, M = BATCH * SEQ;
constexpr int SLOTS = 2 * M + NE * 256;
constexpr float RMS_EPS = 1e-6f;
constexpr size_t MiB = 1u << 20;
constexpr size_t WS_CTL = 0, CTL_ZERO_BYTES = 64 * 1024;
constexpr size_t WS_RSTD = 1 * MiB;
constexpr size_t WS_ROUTE = 2 * MiB;
constexpr size_t WS_LOGF = 3 * MiB;
constexpr size_t WS_WQKV = 8 * MiB, WS_WOA = 14 * MiB, WS_WKVQ = 16 * MiB, WS_WOB = 22 * MiB;
constexpr size_t WS_WGU = 24 * MiB;
constexpr size_t WS_WD = 88 * MiB;
constexpr size_t WS_Q = 120 * MiB, WS_K = 152 * MiB, WS_V = 184 * MiB, WS_XB = 216 * MiB;
constexpr size_t WS_XS = 120 * MiB;
constexpr size_t WS_HS = 192 * MiB;
constexpr size_t WS_END = 248 * MiB;
static_assert(WS_XS + (size_t)SLOTS * D * 2 <= WS_HS && WS_HS + (size_t)SLOTS * FE * 2 <= WS_END, "ws map");
constexpr int CW_CNT = 64;
constexpr int CW_BAR = 4096;
constexpr int RING_BYTES = 131072, LDSCTL_OFF = 139264, MISC_OFF = LDSCTL_OFF + 320, LDS_BYTES = 147456;
constexpr int NPH = 17;

#define GAS __attribute__((address_space(1)))
#define LAS __attribute__((address_space(3)))
typedef unsigned short bf16;
typedef unsigned v4u __attribute__((ext_vector_type(4)));
typedef float f32x4 __attribute__((ext_vector_type(4)));
typedef short bf16x8 __attribute__((ext_vector_type(8)));
typedef GAS unsigned gu32;
typedef GAS unsigned long long gu64;
#define RLX_AGENT __ATOMIC_RELAXED, __HIP_MEMORY_SCOPE_AGENT
#define LDS_WAIT() asm volatile("s_waitcnt lgkmcnt(0)" ::: "memory")
#define VM_WAIT() asm volatile("s_waitcnt vmcnt(0)" ::: "memory")
__device__ __forceinline__ unsigned long long rt() { return __builtin_amdgcn_s_memrealtime(); }
__device__ __forceinline__ unsigned f2bf(float f) { unsigned u = __builtin_bit_cast(unsigned, f); return (u + 0x7fffu + ((u >> 16) & 1u)) >> 16; }
__device__ __forceinline__ unsigned pk2(float lo, float hi) { return f2bf(lo) | (f2bf(hi) << 16); }

#define XB_TMO      128
#define XB_XCNT(j)  (256  + 64 * (j))
#define XB_XSUB(j)  (1280 + 64 * (j))
#define XB_XGEN(j)  (2304 + 64 * (j))
#define XB_TOP      3328
#define XB_TOPGEN   3392
#define XCD_BAR_WORDS 3456
#define XB_SPIN_CAP (1u << 18)

__device__ __forceinline__ unsigned xb_ld(unsigned* p)              { return __hip_atomic_load(p, __ATOMIC_RELAXED, __HIP_MEMORY_SCOPE_AGENT); }
__device__ __forceinline__ unsigned xb_add(unsigned* p, unsigned v) { return __hip_atomic_fetch_add(p, v, __ATOMIC_RELAXED, __HIP_MEMORY_SCOPE_AGENT); }
__device__ __forceinline__ unsigned xb_xcc_id() { return (unsigned)__builtin_amdgcn_s_getreg((3 << 11) | 20) & 0xFu; }
#define XB_SPIN(cond, bar) do { unsigned _sp = 0; while (cond) { __builtin_amdgcn_s_sleep(1); \
    if ((++_sp & 255u) == 0u) { if (xb_ld(&(bar)[XB_TMO])) break; if (_sp > XB_SPIN_CAP) { atomicAdd(&(bar)[XB_TMO], 1u); break; } } } } while (0)

struct XcdBarrier {
    unsigned* bar; unsigned x;
    volatile LAS unsigned* st;
};

__device__ __forceinline__ XcdBarrier xcd_barrier_post(unsigned* bar, volatile LAS unsigned* st) {
    XcdBarrier b; b.bar = bar; b.x = xb_xcc_id(); b.st = st;
    if (threadIdx.x == 0) (void)xb_add(&bar[XB_XCNT(b.x)], 1u);
    return b;
}
__device__ __forceinline__ void xcd_barrier_complete(unsigned* bar, unsigned x, unsigned& nloc, unsigned& nx) {
    const unsigned G = gridDim.x * gridDim.y * gridDim.z;
    unsigned sum, cnt, mine, sp = 0u;
    for (;;) {
        sum = 0u; cnt = 0u; mine = 0u;
#pragma unroll
        for (unsigned j = 0; j < 16; ++j) { const unsigned c = xb_ld(&bar[XB_XCNT(j)]); sum += c; cnt += (c > 0u) ? 1u : 0u; mine = (j == x) ? c : mine; }
        if (sum == G) break;
        __builtin_amdgcn_s_sleep(1);
        if ((++sp & 255u) == 0u) { if (xb_ld(&bar[XB_TMO])) break; if (sp > XB_SPIN_CAP) { atomicAdd(&bar[XB_TMO], 1u); break; } }
    }
    nloc = mine > 0u ? mine : 1u; nx = cnt > 0u ? cnt : 1u;
}

__device__ __forceinline__ void xcd_barrier(const XcdBarrier& b) {
    asm volatile("s_waitcnt vmcnt(0)" ::: "memory");
    __syncthreads();
    if (threadIdx.x == 0) {
        unsigned* bar = b.bar;
        __builtin_amdgcn_s_waitcnt(0);
        unsigned nloc = b.st[0], nx = b.st[1];
        if (nloc == 0u) { xcd_barrier_complete(bar, b.x, nloc, nx); b.st[0] = nloc; b.st[1] = nx; }
        const unsigned old = xb_add(&bar[XB_XSUB(b.x)], 1u);
        const unsigned gen = old / nloc;
        if (old + 1u == (gen + 1u) * nloc) {
            __builtin_amdgcn_fence(__ATOMIC_RELEASE, "agent");
            asm volatile("s_waitcnt vmcnt(0)" ::: "memory");
            const unsigned og = xb_add(&bar[XB_TOP], 1u);
            const unsigned tg = og / nx;
            if (og + 1u == (tg + 1u) * nx) xb_add(&bar[XB_TOPGEN], 1u);
            else XB_SPIN(xb_ld(&bar[XB_TOPGEN]) == tg, bar);
            __builtin_amdgcn_fence(__ATOMIC_ACQUIRE, "agent");
            xb_add(&bar[XB_XGEN(b.x)], 1u);
            asm volatile("s_waitcnt vmcnt(0)" ::: "memory");
        } else {
            XB_SPIN(xb_ld(&bar[XB_XGEN(b.x)]) == gen, bar);
            __builtin_amdgcn_fence(__ATOMIC_ACQUIRE, "agent");
            asm volatile("s_waitcnt vmcnt(0)" ::: "memory");
        }
    }
    __syncthreads();
}

struct Frame {
    LAS unsigned char* lds; volatile LAS unsigned* MISC; gu32* ctl;
    int tid, lane, wave, vcu, G;
};
__device__ __forceinline__ float wave_sum(float v) {
#pragma unroll
    for (int o = 1; o < 64; o <<= 1) v += __shfl_xor(v, o);
    return v;
}
__device__ __forceinline__ unsigned ldu(const unsigned* p) { return __hip_atomic_load(p, __ATOMIC_RELAXED, __HIP_MEMORY_SCOPE_AGENT); }
__device__ __forceinline__ unsigned cvtpk2(float lo, float hi) { typedef float f2 __attribute__((ext_vector_type(2))); typedef __bf16 b2 __attribute__((ext_vector_type(2))); f2 v = {lo, hi}; b2 b = __builtin_convertvector(v, b2); return __builtin_bit_cast(unsigned, b); }
__device__ __forceinline__ float bflo(unsigned w) { return __uint_as_float(w << 16); }
__device__ __forceinline__ float bfhi(unsigned w) { return __uint_as_float(w & 0xffff0000u); }

__device__ __forceinline__ void transpose_item(const float* W, int ldw, int K, const float* gain, bf16* WT, int k0, int n0, int dst_row0, LAS float* scr, int lane) {
    const int kq = lane >> 4, c4 = (lane & 15) * 4;
#pragma unroll 4
    for (int i = 0; i < 16; ++i) { const int kk = 4 * i + kq; f32x4 v = *(const GAS f32x4*)(W + (size_t)(k0 + kk) * ldw + n0 + c4);
        if (gain) v = v * gain[k0 + kk];
        LAS float* s = scr + kk * 65 + c4; s[0] = v.x; s[1] = v.y; s[2] = v.z; s[3] = v.w; }
    LDS_WAIT(); asm volatile("" ::: "memory");
    const int c = 4 * (lane >> 5) + ((lane >> 3) & 3), nl = lane & 7;
#pragma unroll
    for (int j = 0; j < 8; ++j) { const int n = 8 * j + nl; const LAS float* s = scr + (8 * c) * 65 + n;
        v4u o; o.x = cvtpk2(s[0], s[65]); o.y = cvtpk2(s[2 * 65], s[3 * 65]); o.z = cvtpk2(s[4 * 65], s[5 * 65]); o.w = cvtpk2(s[6 * 65], s[7 * 65]);
        *(GAS v4u*)(WT + (size_t)(dst_row0 + n) * K + k0 + 8 * c) = o; }
    LDS_WAIT(); asm volatile("" ::: "memory");
}
struct In {
    const float *x, *attn_norm, *w_qkv_a, *w_o_a, *kv_norm, *w_kvf, *b_f, *w_q_b, *w_o_b, *moe_norm, *w_group, *w_router, *w_gate, *w_up, *w_down, *final_norm;
};
__device__ __forceinline__ void p0_prologue(Frame& F, const In& I, unsigned char* ws) {
    LAS float* scr = (LAS float*)(F.lds + F.wave * 16640);
    const int gw = F.vcu * NWAVES + F.wave, NGW = F.G * NWAVES;
    bf16* Wqkv = (bf16*)(ws + WS_WQKV); bf16* Woa = (bf16*)(ws + WS_WOA); bf16* Wkvq = (bf16*)(ws + WS_WKVQ); bf16* Wob = (bf16*)(ws + WS_WOB);
    bf16* Wgu = (bf16*)(ws + WS_WGU); bf16* Wd = (bf16*)(ws + WS_WD);
    constexpr int I_QKV = 16 * 48, I_SQ = 16 * 16, I_KV = 16 * 32, I_EXP = 32 * 128;
    constexpr int NITEMS = I_QKV + I_SQ + I_KV + I_SQ + I_SQ + 3 * I_EXP;
    for (int it = gw; it < NITEMS; it += NGW) {
        int r = it;
        if (r < I_QKV) { transpose_item(I.w_qkv_a, 3072, 1024, I.attn_norm, Wqkv, 64 * (r / 48), 64 * (r % 48), 64 * (r % 48), scr, F.lane); continue; } r -= I_QKV;
        if (r < I_SQ) { transpose_item(I.w_o_a, 1024, 1024, nullptr, Woa, 64 * (r / 16), 64 * (r % 16), 64 * (r % 16), scr, F.lane); continue; } r -= I_SQ;
        if (r < I_KV) { transpose_item(I.w_kvf, 2064, 1024, I.kv_norm, Wkvq, 64 * (r / 32), 64 * (r % 32), 64 * (r % 32), scr, F.lane); continue; } r -= I_KV;
        if (r < I_SQ) { transpose_item(I.w_q_b, 1024, 1024, I.attn_norm + 1024, Wkvq, 64 * (r / 16), 64 * (r % 16), 2048 + 64 * (r % 16), scr, F.lane); continue; } r -= I_SQ;
        if (r < I_SQ) { transpose_item(I.w_o_b, 1024, 1024, nullptr, Wob, 64 * (r / 16), 64 * (r % 16), 64 * (r % 16), scr, F.lane); continue; } r -= I_SQ;
        if (r < 2 * I_EXP) {
            const int isup = r >= I_EXP; if (isup) r -= I_EXP;
            const int le = r >> 7, q = r & 127, kb = q >> 3, nb = q & 7, f0 = 64 * nb;
            const float* W = (isup ? I.w_up : I.w_gate) + (size_t)le * 1024 * 512;
            transpose_item(W, 512, 1024, nullptr, Wgu + (size_t)le * 1024 * 1024, 64 * kb, f0, 256 * (f0 >> 7) + 128 * isup + (f0 & 127), scr, F.lane); continue; }
        r -= 2 * I_EXP;
        { const int le = r >> 7, q = r & 127, kb = q >> 4, nb = q & 15;
          transpose_item(I.w_down + (size_t)le * 512 * 1024, 1024, 512, nullptr, Wd + (size_t)le * 1024 * 512, 64 * kb, 64 * nb, 64 * nb, scr, F.lane); }
    }
    bf16* XB = (bf16*)(ws + WS_XB); float* rstd = (float*)(ws + WS_RSTD);
    for (int m = gw; m < M; m += NGW) {
        const GAS f32x4* xr = (const GAS f32x4*)(I.x + (size_t)m * D) + F.lane;
        f32x4 v[4]; float s = 0.f;
#pragma unroll
        for (int j = 0; j < 4; ++j) { v[j] = xr[64 * j]; s += (v[j].x * v[j].x + v[j].y * v[j].y) + (v[j].z * v[j].z + v[j].w * v[j].w); }
        s = wave_sum(s);
        GAS unsigned long long* o8 = (GAS unsigned long long*)(XB + (size_t)m * D) + F.lane;
#pragma unroll
        for (int j = 0; j < 4; ++j) o8[64 * j] = (unsigned long long)cvtpk2(v[j].x, v[j].y) | ((unsigned long long)cvtpk2(v[j].z, v[j].w) << 32);
        if (F.lane == 0) rstd[m] = 1.f / sqrtf(s * (1.f / D) + RMS_EPS);
    }
}

constexpr int DOT_STRIDE = 36;
template <int NC1, int NC2>
__device__ __forceinline__ void rowdots_chunk(const LAS float* tile, int lane, int k0, const float* gain, const float* W1, int ld1, const float* W2, int ld2, float& ss, float (&acc)[NC1 + NC2]) {
#pragma unroll 2
    for (int q = 0; q < 8; ++q) { const f32x4 hv = *(const LAS f32x4*)(tile + lane * DOT_STRIDE + 4 * q);
#pragma unroll
        for (int j = 0; j < 4; ++j) { const int k = k0 + 4 * q + j; const float h = hv[j]; ss += h * h; const float hg = h * gain[k];
#pragma unroll
            for (int n = 0; n < NC1; ++n) acc[n] += hg * W1[(size_t)k * ld1 + n];
#pragma unroll
            for (int n = 0; n < NC2; ++n) acc[NC1 + n] += hg * W2[(size_t)k * ld2 + n]; } }
}
__device__ __forceinline__ void slot_bases(Frame& F, const unsigned* cnt, LAS int* sb) {
    if (F.tid == 0) { int s = 0; for (int e = 0; e < 16; ++e) { sb[e] = s; const int c = (int)ldu(cnt + e); s += ((c + 255) >> 8) << 8; } sb[16] = s; }
    __syncthreads();
}

__device__ __forceinline__ void router_phase(Frame& F, const float* h, const float* gain, const float* wg, const float* wr, unsigned* cnt, unsigned* route) {
    LAS float* tile = (LAS float*)(F.lds + F.wave * (64 * DOT_STRIDE * 4));
    LAS float* red = (LAS float*)(F.lds + 8 * 64 * DOT_STRIDE * 4);
    for (int rb = F.vcu; rb < M / 64; rb += F.G) {
        const int r0 = rb * 64; float ss = 0.f; float acc[20];
#pragma unroll
        for (int n = 0; n < 20; ++n) acc[n] = 0.f;
        for (int ch = 0; ch < 4; ++ch) { const int k0 = F.wave * 128 + ch * 32;
#pragma unroll
            for (int i = 0; i < 8; ++i) { const int row = (F.lane >> 3) + 8 * i, c4 = (F.lane & 7) * 4;
                const f32x4 v = *(const GAS f32x4*)(h + (size_t)(r0 + row) * D + k0 + c4); *(LAS f32x4*)(tile + row * DOT_STRIDE + c4) = v; }
            LDS_WAIT(); asm volatile("" ::: "memory");
            rowdots_chunk<4, 16>(tile, F.lane, k0, gain, wg, 4, wr, 16, ss, acc);
            LDS_WAIT(); asm volatile("" ::: "memory");
        }
        __syncthreads();
#pragma unroll
        for (int n = 0; n < 20; ++n) red[(F.wave * 21 + n) * 64 + F.lane] = acc[n];
        red[(F.wave * 21 + 20) * 64 + F.lane] = ss;
        __syncthreads();
        if (F.wave == 0) {
            float a[21];
#pragma unroll
            for (int n = 0; n < 21; ++n) { float s = 0.f;
#pragma unroll
                for (int w = 0; w < 8; ++w) s += red[(w * 21 + n) * 64 + F.lane]; a[n] = s; }
            const float rstd = 1.f / sqrtf(a[20] * (1.f / D) + RMS_EPS);
            float lg[4];
#pragma unroll
            for (int g = 0; g < 4; ++g) lg[g] = a[g] * rstd;
            int gi = 0; float best = lg[0];
#pragma unroll
            for (int g = 1; g < 4; ++g) if (lg[g] > best) { best = lg[g]; gi = g; }
            float den = 0.f;
#pragma unroll
            for (int g = 0; g < 4; ++g) den += __expf(lg[g] - best);
            const float gprob = 1.f / den;
            float le[4];
#pragma unroll
            for (int j = 0; j < 4; ++j) le[j] = rstd * (gi == 0 ? a[4 + j] : gi == 1 ? a[8 + j] : gi == 2 ? a[12 + j] : a[16 + j]);
            int i0 = 0; float t0 = le[0];
#pragma unroll
            for (int j = 1; j < 4; ++j) if (le[j] > t0) { t0 = le[j]; i0 = j; }
            int i1 = -1; float t1 = -INFINITY;
#pragma unroll
            for (int j = 0; j < 4; ++j) if (j != i0 && le[j] > t1) { t1 = le[j]; i1 = j; }
            const float ex = __expf(t1 - t0), w0 = gprob / (1.f + ex), w1 = gprob * ex / (1.f + ex);
            const int e0 = gi * 4 + i0, e1 = gi * 4 + i1;
            int mycount = 0, p0 = 0, p1 = 0; const unsigned long long lt = (1ull << F.lane) - 1ull;
#pragma unroll
            for (int e = 0; e < 16; ++e) { const unsigned long long mk = __ballot(e0 == e || e1 == e); const int c = __popcll(mk), before = __popcll(mk & lt);
                if (F.lane == e) mycount = c; if (e0 == e) p0 = before; if (e1 == e) p1 = before; }
            unsigned basev = 0;
            if (F.lane < 16) basev = __hip_atomic_fetch_add(cnt + F.lane, (unsigned)mycount, __ATOMIC_RELAXED, __HIP_MEMORY_SCOPE_AGENT);
            const unsigned b0 = __shfl(basev, e0), b1 = __shfl(basev, e1);
            unsigned* rt = route + (size_t)(r0 + F.lane) * 8;
            v4u q; q.x = (unsigned)e0 | ((unsigned)e1 << 8); q.y = b0 + (unsigned)p0; q.z = b1 + (unsigned)p1; q.w = __float_as_uint(w0);
            *(v4u*)rt = q; rt[4] = __float_as_uint(w1); rt[5] = __float_as_uint(rstd);
        }
        __syncthreads();
    }
}
__device__ __forceinline__ void gather_phase(Frame& F, const float* h, const float* gain, const unsigned* cnt, const unsigned* route, bf16* Xs) {
    LAS int* sb = (LAS int*)(F.lds + LDSCTL_OFF + 64);
    slot_bases(F, cnt, sb);
    const int gw = F.vcu * NWAVES + F.wave, NGW = F.G * NWAVES;
    f32x4 gv[4];
#pragma unroll
    for (int j = 0; j < 4; ++j) gv[j] = *((const GAS f32x4*)gain + F.lane + 64 * j);
    for (int m = gw; m < M; m += NGW) {
        const unsigned rv = route[(size_t)m * 8 + (F.lane & 7)];
        v4u q; q.x = __builtin_amdgcn_readlane(rv, 0); q.y = __builtin_amdgcn_readlane(rv, 1); q.z = __builtin_amdgcn_readlane(rv, 2); const float rstd = __uint_as_float(__builtin_amdgcn_readlane(rv, 5));
        const int s0 = sb[q.x & 255] + (int)q.y, s1 = sb[(q.x >> 8) & 255] + (int)q.z;
        const GAS f32x4* xr = (const GAS f32x4*)(h + (size_t)m * D) + F.lane;
        GAS unsigned long long* o0 = (GAS unsigned long long*)(Xs + (size_t)s0 * D) + F.lane; GAS unsigned long long* o1 = (GAS unsigned long long*)(Xs + (size_t)s1 * D) + F.lane;
#pragma unroll
        for (int j = 0; j < 4; ++j) { const f32x4 v = xr[64 * j] * gv[j] * rstd; const unsigned long long w = (unsigned long long)cvtpk2(v.x, v.y) | ((unsigned long long)cvtpk2(v.z, v.w) << 32); o0[64 * j] = w; o1[64 * j] = w; }
    }
}
__device__ __forceinline__ void combine_prep_phase(Frame& F, float* h, const bf16* Y, const unsigned* cnt, const unsigned* route, const float* kvg, const float* wkvf, const float* bf_, bf16* XB, float* rstd_out, float* logf) {
    LAS int* sb = (LAS int*)(F.lds + LDSCTL_OFF + 64);
    slot_bases(F, cnt, sb);
    LAS float* tile = (LAS float*)(F.lds + F.wave * (64 * DOT_STRIDE * 4));
    LAS float* red = (LAS float*)(F.lds + 8 * 64 * DOT_STRIDE * 4);
    for (int rb = F.vcu; rb < M / 64; rb += F.G) {
        const int r0 = rb * 64; float ss = 0.f; float acc[16];
#pragma unroll
        for (int n = 0; n < 16; ++n) acc[n] = 0.f;
        for (int ch = 0; ch < 4; ++ch) { const int k0 = F.wave * 128 + ch * 32;
#pragma unroll
            for (int i = 0; i < 8; ++i) { const int row = (F.lane >> 3) + 8 * i, c4 = (F.lane & 7) * 4; const size_t m = (size_t)(r0 + row);
                const v4u q = *(const GAS v4u*)(route + m * 8); const float w0 = __uint_as_float(q.w), w1 = __uint_as_float(ldu(route + m * 8 + 4));
                const int s0 = sb[q.x & 255] + (int)q.y, s1 = sb[(q.x >> 8) & 255] + (int)q.z;
                f32x4 v = *(const GAS f32x4*)(h + m * D + k0 + c4);
                const unsigned long long y0 = *(const GAS unsigned long long*)(Y + (size_t)s0 * D + k0 + c4), y1 = *(const GAS unsigned long long*)(Y + (size_t)s1 * D + k0 + c4);
                const unsigned y0l = (unsigned)y0, y0h = (unsigned)(y0 >> 32), y1l = (unsigned)y1, y1h = (unsigned)(y1 >> 32);
                v.x += w0 * bflo(y0l) + w1 * bflo(y1l); v.y += w0 * bfhi(y0l) + w1 * bfhi(y1l); v.z += w0 * bflo(y0h) + w1 * bflo(y1h); v.w += w0 * bfhi(y0h) + w1 * bfhi(y1h);
                *(GAS f32x4*)(h + m * D + k0 + c4) = v;
                *(GAS unsigned long long*)(XB + m * D + k0 + c4) = (unsigned long long)cvtpk2(v.x, v.y) | ((unsigned long long)cvtpk2(v.z, v.w) << 32);
                *(LAS f32x4*)(tile + row * DOT_STRIDE + c4) = v; }
            LDS_WAIT(); asm volatile("" ::: "memory");
            rowdots_chunk<16, 0>(tile, F.lane, k0, kvg, wkvf + 2048, 2064, nullptr, 0, ss, acc);
            LDS_WAIT(); asm volatile("" ::: "memory");
        }
        __syncthreads();
#pragma unroll
        for (int n = 0; n < 16; ++n) red[(F.wave * 17 + n) * 64 + F.lane] = acc[n];
        red[(F.wave * 17 + 16) * 64 + F.lane] = ss;
        __syncthreads();
        if (F.wave == 0) {
            float a[17];
#pragma unroll
            for (int n = 0; n < 17; ++n) { float s = 0.f;
#pragma unroll
                for (int w = 0; w < 8; ++w) s += red[(w * 17 + n) * 64 + F.lane]; a[n] = s; }
            const float rstd = 1.f / sqrtf(a[16] * (1.f / D) + RMS_EPS);
            rstd_out[r0 + F.lane] = rstd;
            float lf[16];
#pragma unroll
            for (int n = 0; n < 16; ++n) { const float xg = a[n] * rstd + bf_[n]; lf[n] = fminf(xg, 0.f) - log1pf(__expf(-fabsf(xg))); }
            GAS f32x4* lo = (GAS f32x4*)(logf + (size_t)(r0 + F.lane) * 16);
#pragma unroll
            for (int j = 0; j < 4; ++j) lo[j] = (f32x4){lf[4 * j], lf[4 * j + 1], lf[4 * j + 2], lf[4 * j + 3]};
        }
        __syncthreads();
    }
}
__device__ __forceinline__ void final_phase(Frame& F, float* h, const bf16* Y, const unsigned* cnt, const unsigned* route, const float* gain) {
    LAS int* sb = (LAS int*)(F.lds + LDSCTL_OFF + 64);
    slot_bases(F, cnt, sb);
    const int gw = F.vcu * NWAVES + F.wave, NGW = F.G * NWAVES;
    f32x4 gv[4];
#pragma unroll
    for (int j = 0; j < 4; ++j) gv[j] = *((const GAS f32x4*)gain + F.lane + 64 * j);
    for (int m = gw; m < M; m += NGW) {
        const unsigned rv = route[(size_t)m * 8 + (F.lane & 7)];
        v4u q; q.x = __builtin_amdgcn_readlane(rv, 0); q.y = __builtin_amdgcn_readlane(rv, 1); q.z = __builtin_amdgcn_readlane(rv, 2);
        const float w0 = __uint_as_float(__builtin_amdgcn_readlane(rv, 3)), w1 = __uint_as_float(__builtin_amdgcn_readlane(rv, 4));
        const int s0 = sb[q.x & 255] + (int)q.y, s1 = sb[(q.x >> 8) & 255] + (int)q.z;
        GAS f32x4* xr = (GAS f32x4*)(h + (size_t)m * D) + F.lane;
        const GAS unsigned long long* y0p = (const GAS unsigned long long*)(Y + (size_t)s0 * D) + F.lane; const GAS unsigned long long* y1p = (const GAS unsigned long long*)(Y + (size_t)s1 * D) + F.lane;
        f32x4 v[4]; float s = 0.f;
#pragma unroll
        for (int j = 0; j < 4; ++j) { v[j] = xr[64 * j]; const unsigned long long y0 = y0p[64 * j], y1 = y1p[64 * j];
            const unsigned y0l = (unsigned)y0, y0h = (unsigned)(y0 >> 32), y1l = (unsigned)y1, y1h = (unsigned)(y1 >> 32);
            v[j].x += w0 * bflo(y0l) + w1 * bflo(y1l); v[j].y += w0 * bfhi(y0l) + w1 * bfhi(y1l); v[j].z += w0 * bflo(y0h) + w1 * bflo(y1h); v[j].w += w0 * bfhi(y0h) + w1 * bfhi(y1h);
            s += (v[j].x * v[j].x + v[j].y * v[j].y) + (v[j].z * v[j].z + v[j].w * v[j].w); }
        const float rstd = 1.f / sqrtf(wave_sum(s) * (1.f / D) + RMS_EPS);
#pragma unroll
        for (int j = 0; j < 4; ++j) xr[64 * j] = v[j] * gv[j] * rstd;
    }
}

struct Args { const float* in[16]; float* out; unsigned char* ws; int ph_lo, ph_hi; };
__global__ void __launch_bounds__(NWAVES * 64, 2) fwd_kernel(Args args) {
    extern __shared__ __attribute__((aligned(16))) unsigned char lds[];
    Frame F;
    F.lds = (LAS unsigned char*)lds;
    F.MISC = (volatile LAS unsigned*)(F.lds + MISC_OFF);
    F.tid = threadIdx.x; F.lane = F.tid & 63; F.wave = __builtin_amdgcn_readfirstlane(F.tid >> 6);
    F.G = gridDim.x; { const int bx = blockIdx.x; F.vcu = (F.G % 8 == 0) ? (bx % 8) * (F.G / 8) + bx / 8 : bx; }
    unsigned char* ws = args.ws;
    F.ctl = (gu32*)(ws + WS_CTL);
    In I; I.x = args.in[0]; I.attn_norm = args.in[1]; I.w_qkv_a = args.in[2]; I.w_o_a = args.in[3]; I.kv_norm = args.in[4]; I.w_kvf = args.in[5]; I.b_f = args.in[6]; I.w_q_b = args.in[7];
    I.w_o_b = args.in[8]; I.moe_norm = args.in[9]; I.w_group = args.in[10]; I.w_router = args.in[11]; I.w_gate = args.in[12]; I.w_up = args.in[13]; I.w_down = args.in[14]; I.final_norm = args.in[15];
    float* hres = args.out;
    bf16* Wqkv = (bf16*)(ws + WS_WQKV); bf16* Woa = (bf16*)(ws + WS_WOA); bf16* Wkvq = (bf16*)(ws + WS_WKVQ); bf16* Wob = (bf16*)(ws + WS_WOB);
    bf16* Wgu = (bf16*)(ws + WS_WGU); bf16* Wd = (bf16*)(ws + WS_WD);
    bf16* Qb = (bf16*)(ws + WS_Q); bf16* Kb = (bf16*)(ws + WS_K); bf16* Vb = (bf16*)(ws + WS_V); bf16* XB = (bf16*)(ws + WS_XB);
    bf16* Xs = (bf16*)(ws + WS_XS); bf16* Hs = (bf16*)(ws + WS_HS); bf16* Yb = Xs;
    float* rstd = (float*)(ws + WS_RSTD); unsigned* route = (unsigned*)(ws + WS_ROUTE); float* logf = (float*)(ws + WS_LOGF);
    unsigned* cntw = (unsigned*)(ws + WS_CTL) + CW_CNT;
    for (int u = F.tid; u < (LDS_BYTES - LDSCTL_OFF) / 4; u += NWAVES * 64) ((LAS unsigned*)(F.lds + LDSCTL_OFF))[u] = 0u;
    __syncthreads();
    const int lo = args.ph_lo, hi = args.ph_hi;
    const bool multi = (hi - lo) > 1;
    XcdBarrier bar; bar.bar = (unsigned*)(F.ctl + CW_BAR); bar.x = 0; bar.st = nullptr;
    if (multi) bar = xcd_barrier_post((unsigned*)(F.ctl + CW_BAR), F.MISC + 8);
#ifndef PHMASK
#define PHMASK 0x1ffffu
#endif
#define IN(k) (((PHMASK >> (k)) & 1u) && lo <= (k) && (k) < hi)
#define SEAM(k) do { if (IN(k) && IN((k) + 1)) xcd_barrier(bar); } while (0)
    LAS unsigned char* ring = F.lds;
    LAS int* sbt = (LAS int*)(F.lds + LDSCTL_OFF + 64);

    if (IN(0)) { p0_prologue(F, I, ws); } SEAM(0);
    if (IN(1)) {
        pg8::Gemm g{XB, Wqkv, M, 3072, D}; pg8::StaticOrder S; S.init(M, 3072, F.G, (int)blockIdx.x);
        pg8::EpiSplit3 E{Qb, (size_t)(WS_K - WS_Q) / 2, 0, rstd, 0, att::C2};
        pg8::gemm_phase<pg8::EpiSplit3, pg8::StaticOrder, true, true>(ring, g, S, E);
    } SEAM(1);
    if (IN(2)) { att::attn_phase<0>((ALAS char*)ring, F.vcu, F.G, Qb, Kb, Vb, Qb, nullptr); } SEAM(2);
    if (IN(3)) {
        pg8::Gemm g{Qb, Woa, M, D, D}; pg8::StaticOrder S; S.init(M, D, F.G, (int)blockIdx.x);
        pg8::EpiResid E{I.x, hres, D};
        pg8::gemm_phase<pg8::EpiResid, pg8::StaticOrder, true, true>(ring, g, S, E);
    } SEAM(3);
#define MOE_LAYER(l, pb) do { \
        unsigned* cnt = cntw + 64 * (l); \
        if (IN(pb)) { router_phase(F, hres, I.moe_norm + (l) * D, I.w_group + (size_t)(l) * D * 4, I.w_router + (size_t)(l) * D * 16, cnt, route); } SEAM(pb); \
        if (IN((pb) + 1)) { gather_phase(F, hres, I.moe_norm + (l) * D, cnt, route, Xs); } SEAM((pb) + 1); \
        if (IN((pb) + 2)) { \
            slot_bases(F, cnt, sbt); \
            if (F.tid < 17) sbt[32 + F.tid] = sbt[F.tid] >> 8; \
            __syncthreads(); \
            pg8::MoeOrder S; S.pt = (const PG8_LAS int*)(sbt + 32); S.nwg = (sbt[16] >> 8) * 4; S.G = F.G; S.c = (int)blockIdx.x; \
            pg8::Gemm g{Xs, Wgu + (size_t)(l) * 16 * 1024 * 1024, SLOTS, 1024, D}; \
            pg8::EpiGateUp E{Hs}; \
            pg8::gemm_phase<pg8::EpiGateUp, pg8::MoeOrder, true, true>(ring, g, S, E); \
        } SEAM((pb) + 2); \
        if (IN((pb) + 3)) { \
            slot_bases(F, cnt, sbt); \
            if (F.tid < 17) sbt[32 + F.tid] = sbt[F.tid] >> 8; \
            __syncthreads(); \
            pg8::MoeOrder S; S.pt = (const PG8_LAS int*)(sbt + 32); S.nwg = (sbt[16] >> 8) * 4; S.G = F.G; S.c = (int)blockIdx.x; \
            pg8::Gemm g{Hs, Wd + (size_t)(l) * 16 * 1024 * 512, SLOTS, 1024, FE}; \
            pg8::EpiBf16Plain E{Yb, D}; \
            pg8::gemm_phase<pg8::EpiBf16Plain, pg8::MoeOrder, true, true>(ring, g, S, E); \
        } SEAM((pb) + 3); \
    } while (0)
    MOE_LAYER(0, 4);
    if (IN(8)) { combine_prep_phase(F, hres, Yb, cntw, route, I.kv_norm, I.w_kvf, I.b_f, XB, rstd, logf); } SEAM(8);
    if (IN(9)) {
        pg8::Gemm g{XB, Wkvq, M, 3072, D}; pg8::StaticOrder S; S.init(M, 3072, F.G, (int)blockIdx.x);
        pg8::EpiSplit3 E{Qb, (size_t)(WS_K - WS_Q) / 2, 1, rstd, 2, att::C2};
        pg8::gemm_phase<pg8::EpiSplit3, pg8::StaticOrder, true, true>(ring, g, S, E);
    } SEAM(9);
    if (IN(10)) { att::attn_phase<1>((ALAS char*)ring, F.vcu, F.G, Qb, Kb, Vb, Qb, logf); } SEAM(10);
    if (IN(11)) {
        pg8::Gemm g{Qb, Wob, M, D, D}; pg8::StaticOrder S; S.init(M, D, F.G, (int)blockIdx.x);
        pg8::EpiResid E{hres, hres, D};
        pg8::gemm_phase<pg8::EpiResid, pg8::StaticOrder, true, true>(ring, g, S, E);
    } SEAM(11);
    MOE_LAYER(1, 12);
    if (IN(16)) { final_phase(F, hres, Yb, cntw + 64, route, I.final_norm); }
#undef IN
#undef SEAM
}

#ifndef N_LAUNCH_MODE
#define N_LAUNCH_MODE 0
#endif
extern "C" void kernel_launch(void* const* d_in, const int* in_sizes, int n_in, void* d_out, int out_size, void* d_ws, size_t ws_size, hipStream_t stream) {
    static int grid = 0;
    if (grid == 0) {
        if (n_in != 16 || out_size != M * D || ws_size < WS_END) { fprintf(stderr, "kernel_launch: unexpected shapes (n_in %d, out %d, ws %zu)\n", n_in, out_size, ws_size); grid = -1; return; }
        int dev = 0, cus = 0;
        if (hipGetDevice(&dev) != hipSuccess || hipDeviceGetAttribute(&cus, hipDeviceAttributeMultiprocessorCount, dev) != hipSuccess) { grid = -1; return; }
        if (hipFuncSetAttribute((const void*)fwd_kernel, hipFuncAttributeMaxDynamicSharedMemorySize, LDS_BYTES) != hipSuccess) { fprintf(stderr, "kernel_launch: hipFuncSetAttribute failed\n"); grid = -1; return; }
        int per_cu = 0;
        if (hipOccupancyMaxActiveBlocksPerMultiprocessor(&per_cu, (const void*)fwd_kernel, NWAVES * 64, LDS_BYTES) != hipSuccess || per_cu < 1) fprintf(stderr, "kernel_launch: occupancy query says %d\n", per_cu);
        (void)hipGetLastError();
        grid = cus;
    }
    if (grid < 0) return;
    (void)hipMemsetAsync((char*)d_ws + WS_CTL, 0, CTL_ZERO_BYTES, stream);
    Args a{};
    for (int i = 0; i < 16; ++i) a.in[i] = (const float*)d_in[i];
    a.out = (float*)d_out; a.ws = (unsigned char*)d_ws;
#if N_LAUNCH_MODE == 1
    a.ph_lo = 0; a.ph_hi = NPH;
    void* kargs[] = {&a};
    hipError_t e = hipLaunchCooperativeKernel((const void*)fwd_kernel, dim3(grid), dim3(NWAVES * 64), kargs, LDS_BYTES, stream);
    if (e != hipSuccess) fprintf(stderr, "kernel_launch: cooperative launch failed: %s (grid %d)\n", hipGetErrorString(e), grid);
#else
    for (int p = 0; p < NPH; ++p) { a.ph_lo = p; a.ph_hi = p + 1; hipLaunchKernelGGL(fwd_kernel, dim3(grid), dim3(NWAVES * 64), LDS_BYTES, stream, a); }
#endif
}
```

```cpp
#include <hip/hip_runtime.h>
#include <cstdio>
#include <cstdint>
#include <hip/hip_bf16.h>
#include <cmath>
namespace pg8 {
#define PG8_LAS __attribute__((address_space(3)))
typedef unsigned short bf16_t;
typedef short bf16x8 __attribute__((ext_vector_type(8)));
typedef float f32x4 __attribute__((ext_vector_type(4)));
typedef unsigned u32x4 __attribute__((ext_vector_type(4)));
constexpr int BM = 256, BK = 64, HALF = 128, HTB = HALF * BK * 2  , STAGE_BYTES = 8 * HTB, NXCD = 8, WGM = 8;

__host__ __device__ __forceinline__ int lds_byte(int r, int c) { const int st = (r >> 4) * 2 + (c >> 5), rr = r & 15, cc = c & 31, ob = rr * 64 + cc * 2; return st * 1024 + (ob ^ (((ob >> 9) & 1) << 5)); }
__host__ __device__ __forceinline__ void stage_rc(int b, int& R, int& C) { const int st = b / 1024, sb = b % 1024, swz = sb ^ (((sb >> 9) & 1) << 5); R = (st >> 1) * 16 + swz / 64; C = (st & 1) * 32 + (swz % 64) / 2; }
__host__ __device__ __forceinline__ int perm32(int rho) { const int n = rho >> 4, i = rho & 15; return 8 * (i >> 2) + 4 * n + (i & 3); }

struct Unit { int pm, pn, pb, ui; };
struct Gemm { const bf16_t* A; const bf16_t* Bt; int M, N, K; };
struct StaticOrder {
    int nM, nN, nwg, G, c;
    __host__ __device__ void init(int M, int N, int G_, int c_) { nM = M / BM; nN = N / BM; nwg = nM * nN; G = G_; c = c_; }
    __host__ __device__ __forceinline__ bool next(int i, Unit& u) const {
        const long L = (long)i * G + c; if (L >= nwg) return false;
        int wgid = (int)L; { const int q = nwg / NXCD, r = nwg % NXCD, xcd = wgid % NXCD, off = wgid / NXCD; wgid = (xcd < r ? xcd * (q + 1) : r * (q + 1) + (xcd - r) * q) + off; }
        const int nig = WGM * nN, gid = wgid / nig, fm = gid * WGM, gsz = (nM - fm) < WGM ? (nM - fm) : WGM;
        u.pm = fm + ((wgid % nig) % gsz); u.pn = (wgid % nig) / gsz; u.pb = u.pn; u.ui = i; return true;
    }
    __device__ __forceinline__ void a_ready(const Unit&) const {}
    __device__ __forceinline__ void done(const Unit&) const {}
};
struct MoeOrder {
    const PG8_LAS int* pt; int nwg, G, c; const PG8_LAS int* rowidx;
    __device__ __forceinline__ bool next(int i, Unit& u) const {
        const long L = (long)i * G + c; if (L >= nwg) return false;
        int wgid = (int)L; { const int q = nwg / NXCD, r = nwg % NXCD, xcd = wgid % NXCD, off = wgid / NXCD; wgid = (xcd < r ? xcd * (q + 1) : r * (q + 1) + (xcd - r) * q) + off; }
        const int rt = wgid >> 2, j = wgid & 3; int e = 0;
#pragma unroll
        for (int k = 1; k < 16; ++k) e += (pt[k] <= rt) ? 1 : 0;
        u.pm = rt; u.pn = j; u.pb = e * 4 + j; u.ui = i; return true;
    }
    __device__ __forceinline__ void a_ready(const Unit&) const {}
    __device__ __forceinline__ void done(const Unit&) const {}
};

__device__ __forceinline__ unsigned cvt_pk_bf16(float lo, float hi) { unsigned r; asm volatile("v_cvt_pk_bf16_f32 %0, %1, %2" : "=v"(r) : "v"(lo), "v"(hi)); return r; }
struct EpiSplit3 {
    static constexpr bool PERM = true, AFTER_DRAIN = false;
    bf16_t* O0; size_t ostride; int rot; const float* rstd; int qsel; float qscale;
    __device__ __forceinline__ void operator()(const f32x4 (&acc)[2][2][4][2], const Unit& u, int wr, int wc, int fr, int fq) const {
        const int row0 = u.pm * BM + wr * 64 + fr; int colt = u.pn * BM; const int t = colt >> 10; colt &= 1023;
        int tb = t + rot; tb = tb >= 3 ? tb - 3 : tb; bf16_t* base = O0 + (size_t)tb * ostride; const float sc = (t == qsel) ? qscale : 1.f;
        const int col0 = colt + wc * 32 + 8 * fq;
#pragma unroll
        for (int ai = 0; ai < 2; ++ai)
#pragma unroll
            for (int m = 0; m < 4; ++m) { const int row = row0 + ai * HALF + m * 16; const float rs = rstd[row] * sc; bf16_t* rowp = base + (size_t)row * 1024 + col0;
#pragma unroll
                for (int bj = 0; bj < 2; ++bj) { const f32x4 v0 = acc[ai][bj][m][0] * rs, v1 = acc[ai][bj][m][1] * rs;
                    u32x4 w; w.x = cvt_pk_bf16(v0[0], v0[1]); w.y = cvt_pk_bf16(v0[2], v0[3]); w.z = cvt_pk_bf16(v1[0], v1[1]); w.w = cvt_pk_bf16(v1[2], v1[3]);
                    *(u32x4*)(rowp + bj * HALF) = w; } }
    }
};
template <bool BASE_BF16>
struct EpiResidBf {
    static constexpr bool PERM = true, AFTER_DRAIN = false;
    const void* base; bf16_t* out; int ldc;
    __device__ __forceinline__ void operator()(const f32x4 (&acc)[2][2][4][2], const Unit& u, int wr, int wc, int fr, int fq) const {
        const int row0 = u.pm * BM + wr * 64 + fr, col0 = u.pn * BM + wc * 32 + 8 * fq;
#pragma unroll
        for (int ai = 0; ai < 2; ++ai)
#pragma unroll
            for (int m = 0; m < 4; ++m) { const size_t off = (size_t)(row0 + ai * HALF + m * 16) * ldc + col0;
#pragma unroll
                for (int bj = 0; bj < 2; ++bj) { f32x4 b0, b1;
                    if (BASE_BF16) { const u32x4 q = *(const u32x4*)((const bf16_t*)base + off + bj * HALF);
                        b0 = (f32x4){__uint_as_float(q.x << 16), __uint_as_float(q.x & 0xffff0000u), __uint_as_float(q.y << 16), __uint_as_float(q.y & 0xffff0000u)};
                        b1 = (f32x4){__uint_as_float(q.z << 16), __uint_as_float(q.z & 0xffff0000u), __uint_as_float(q.w << 16), __uint_as_float(q.w & 0xffff0000u)}; }
                    else { b0 = *(const f32x4*)((const float*)base + off + bj * HALF); b1 = *(const f32x4*)((const float*)base + off + bj * HALF + 4); }
                    const f32x4 v0 = b0 + acc[ai][bj][m][0], v1 = b1 + acc[ai][bj][m][1];
                    u32x4 w; w.x = cvt_pk_bf16(v0[0], v0[1]); w.y = cvt_pk_bf16(v0[2], v0[3]); w.z = cvt_pk_bf16(v1[0], v1[1]); w.w = cvt_pk_bf16(v1[2], v1[3]);
                    *(u32x4*)(out + off + bj * HALF) = w; } }
    }
};
struct EpiGateUp {
    static constexpr bool PERM = true, AFTER_DRAIN = false;
    bf16_t* H; const PG8_LAS float* rstab;
    __device__ __forceinline__ void operator()(const f32x4 (&acc)[2][2][4][2], const Unit& u, int wr, int wc, int fr, int fq) const {
        const int row0 = u.pm * BM + wr * 64 + fr, col0 = u.pn * HALF + wc * 32 + 8 * fq;
#pragma unroll
        for (int ai = 0; ai < 2; ++ai)
#pragma unroll
            for (int m = 0; m < 4; ++m) { bf16_t* rowp = H + (size_t)(row0 + ai * HALF + m * 16) * 512 + col0; float hv[8]; const float rs = rstab[u.ui * 256 + ai * HALF + wr * 64 + m * 16 + fr];
#pragma unroll
                for (int n = 0; n < 2; ++n)
#pragma unroll
                    for (int j = 0; j < 4; ++j) { const float g = acc[ai][0][m][n][j] * rs, up = acc[ai][1][m][n][j] * rs;
                        hv[n * 4 + j] = g * __builtin_amdgcn_rcpf(1.f + __builtin_amdgcn_exp2f(-1.4426950408889634f * g)) * up; }
                u32x4 w; w.x = cvt_pk_bf16(hv[0], hv[1]); w.y = cvt_pk_bf16(hv[2], hv[3]); w.z = cvt_pk_bf16(hv[4], hv[5]); w.w = cvt_pk_bf16(hv[6], hv[7]);
                *(u32x4*)rowp = w; }
    }
};
struct EpiBf16Plain {
    static constexpr bool PERM = true, AFTER_DRAIN = false;
    bf16_t* O; int ldc;
    __device__ __forceinline__ void operator()(const f32x4 (&acc)[2][2][4][2], const Unit& u, int wr, int wc, int fr, int fq) const {
        const int row0 = u.pm * BM + wr * 64 + fr, col0 = u.pn * BM + wc * 32 + 8 * fq;
#pragma unroll
        for (int ai = 0; ai < 2; ++ai)
#pragma unroll
            for (int m = 0; m < 4; ++m) { bf16_t* rowp = O + (size_t)(row0 + ai * HALF + m * 16) * ldc + col0;
#pragma unroll
                for (int bj = 0; bj < 2; ++bj) { const f32x4 v0 = acc[ai][bj][m][0], v1 = acc[ai][bj][m][1];
                    u32x4 w; w.x = cvt_pk_bf16(v0[0], v0[1]); w.y = cvt_pk_bf16(v0[2], v0[3]); w.z = cvt_pk_bf16(v1[0], v1[1]); w.w = cvt_pk_bf16(v1[2], v1[3]);
                    *(u32x4*)(rowp + bj * HALF) = w; } }
    }
};

template <class Epi, class Sched, bool ALIGN_EPI = false, bool SP2 = false, bool GATHER = false>
__device__ __forceinline__ void gemm_phase(PG8_LAS unsigned char* lds, const Gemm g, const Sched& S, const Epi& E) {
    const int tid = threadIdx.x, wid = __builtin_amdgcn_readfirstlane(tid >> 6), lane = tid & 63, wr = wid >> 2, wc = wid & 3, fr = lane & 15, fq = lane >> 4;
    const int K = g.K, nt = K / BK;
    static_assert(!GATHER || SP2, "gather mode is written for the SP2 loop");
    unsigned voffA[2], voffB[2]; int RA[2], CA[2];
#pragma unroll
    for (int i = 0; i < 2; ++i) { int R, C; stage_rc(tid * 16 + i * 8192, R, C); const int Rb = Epi::PERM ? ((R & ~31) + perm32(R & 31)) : R; RA[i] = R; CA[i] = C;
        voffA[i] = (unsigned)(R * K + C) * 2u; voffB[i] = (unsigned)(Rb * K + C) * 2u; }
    unsigned vAc[2][2], vAn[2][2];
#define PG8_ROWS(dst, uidx) do { if constexpr (GATHER) { _Pragma("unroll") for (int h_ = 0; h_ < 2; ++h_) _Pragma("unroll") for (int i_ = 0; i_ < 2; ++i_) \
        dst[h_][i_] = (unsigned)(S.rowidx[(uidx) * 256 + 128 * h_ + RA[i_]] * K + CA[i_]) * 2u; } } while (0)
#define PG8_STAGE_A(bufoff, gb, h, NX) do { if constexpr (GATHER) { unsigned vv_[2] = {(NX) ? vAn[h][0] : vAc[h][0], (NX) ? vAn[h][1] : vAc[h][1]}; PG8_STAGE(bufoff, gb, vv_); } \
        else { PG8_STAGE(bufoff, (gb) + (h) * hstep, voffA); } } while (0)
    const size_t kstep = (size_t)(BK * 2);
    const size_t hstep = (size_t)HALF * K * 2;
    const size_t tstep = 2 * hstep;
    const unsigned ldsw = (unsigned)wid * 1024u;
    const int aoff = lds_byte(wr * 64 + fr, fq * 8), boff = lds_byte(wc * 32 + fr, fq * 8);
#define PG8_SA(b, h) (((b) * 2 + (h)) * HTB)
#define PG8_SB(b, h) ((4 + (b) * 2 + (h)) * HTB)
#define PG8_STAGE(bufoff, gbase, voff) do { _Pragma("unroll") for (int _i = 0; _i < 2; ++_i) \
        __builtin_amdgcn_global_load_lds((const unsigned*)((const char*)(gbase) + (voff)[_i]), (PG8_LAS unsigned*)(lds + (bufoff) + ldsw + _i * 8192), 16, 0, 0); } while (0)
#define PG8_LDA(dst, b, h) do { _Pragma("unroll") for (int m = 0; m < 4; ++m) _Pragma("unroll") for (int k = 0; k < 2; ++k) dst[m][k] = *(const PG8_LAS bf16x8*)(lds + PG8_SA(b, h) + aoff + m * 2048 + k * 1024); } while (0)
#define PG8_LDB(dst, b, h) do { _Pragma("unroll") for (int n = 0; n < 2; ++n) _Pragma("unroll") for (int k = 0; k < 2; ++k) dst[n][k] = *(const PG8_LAS bf16x8*)(lds + PG8_SB(b, h) + boff + n * 2048 + k * 1024); } while (0)
#define PG8_MMA(ai, bj, At, Bt) do { __builtin_amdgcn_s_setprio(1); _Pragma("unroll") for (int m = 0; m < 4; ++m) _Pragma("unroll") for (int n = 0; n < 2; ++n) _Pragma("unroll") for (int k = 0; k < 2; ++k) \
        acc[ai][bj][m][n] = __builtin_amdgcn_mfma_f32_16x16x32_bf16(Bt[n][k], At[m][k], acc[ai][bj][m][n], 0, 0, 0); __builtin_amdgcn_s_setprio(0); } while (0)
#define PG8_WAIT_V(n) asm volatile("s_waitcnt vmcnt(" #n ")" ::: "memory")
#define PG8_WAIT_L(n) asm volatile("s_waitcnt lgkmcnt(" #n ")" ::: "memory")
#define PG8_BAR __builtin_amdgcn_s_barrier()
#define PG8_SCHED __builtin_amdgcn_sched_barrier(0)
    Unit cur, nxt; int ui = 0;
    if (!S.next(0, cur)) return;
    f32x4 acc[2][2][4][2];
#pragma unroll
    for (int a = 0; a < 2; ++a)
#pragma unroll
        for (int b = 0; b < 2; ++b)
#pragma unroll
            for (int m = 0; m < 4; ++m)
#pragma unroll
                for (int n = 0; n < 2; ++n) acc[a][b][m][n] = (f32x4){0.f, 0.f, 0.f, 0.f};
    bf16x8 At[4][2], B0[2][2], B1[2][2];
    const char* cA = (const char*)g.A + (GATHER ? (size_t)0 : (size_t)cur.pm * tstep); const char* cB = (const char*)g.Bt + (size_t)cur.pb * tstep;
    PG8_ROWS(vAc, 0); PG8_ROWS(vAn, 0);
    S.a_ready(cur);
    if constexpr (SP2) {
        PG8_STAGE(PG8_SB(0, 0), cB, voffB); PG8_STAGE(PG8_SB(0, 1), cB + hstep, voffB); PG8_STAGE_A(PG8_SA(0, 0), cA, 0, false); PG8_STAGE_A(PG8_SA(0, 1), cA, 1, false);
        if (wr == 1) PG8_BAR;
        PG8_WAIT_V(2); PG8_BAR;
        PG8_STAGE(PG8_SB(1, 0), cB + kstep, voffB); PG8_STAGE_A(PG8_SA(1, 0), cA + kstep, 0, false); PG8_STAGE(PG8_SB(1, 1), cB + hstep + kstep, voffB);
        PG8_WAIT_V(6); PG8_BAR;
    } else {
        PG8_STAGE(PG8_SB(0, 0), cB, voffB); PG8_STAGE(PG8_SA(0, 0), cA, voffA); PG8_STAGE(PG8_SB(0, 1), cB + hstep, voffB); PG8_STAGE(PG8_SA(0, 1), cA + hstep, voffA);
        if (wr == 1) PG8_BAR;
        PG8_WAIT_V(4); PG8_BAR;
        PG8_STAGE(PG8_SB(1, 0), cB + kstep, voffB); PG8_STAGE(PG8_SA(1, 0), cA + kstep, voffA); PG8_STAGE(PG8_SB(1, 1), cB + hstep + kstep, voffB);
        PG8_WAIT_V(6); PG8_BAR;
    }
    for (;;) {
        const bool has_next = S.next(ui + 1, nxt);
        if (has_next) PG8_ROWS(vAn, ui + 1);
        const char* nA = has_next ? (const char*)g.A + (GATHER ? (size_t)0 : (size_t)nxt.pm * tstep) : cA; const char* nB = has_next ? (const char*)g.Bt + (size_t)nxt.pb * tstep : cB;
        for (int t = 0; t < nt; t += 2) {
            const bool last = (t == nt - 2);
            const char* a1 = cA + (size_t)(t + 1) * kstep;
            const char* a2 = last ? nA : cA + (size_t)(t + 2) * kstep; const char* b2 = last ? nB : cB + (size_t)(t + 2) * kstep;
            const char* a3 = a2 + kstep; const char* b3 = b2 + kstep;
            if (last && has_next) S.a_ready(nxt);
            if constexpr (SP2) {
            PG8_LDB(B0, 0, 0); PG8_LDB(B1, 0, 1); PG8_SCHED; PG8_LDA(At, 0, 0); PG8_STAGE_A(PG8_SA(1, 1), a1, 1, false);
            PG8_WAIT_V(8); PG8_WAIT_L(0); PG8_BAR; PG8_MMA(0, 0, At, B0); PG8_MMA(0, 1, At, B1); PG8_BAR; PG8_SCHED;
            PG8_LDA(At, 0, 1); PG8_STAGE(PG8_SB(0, 0), b2, voffB); PG8_STAGE(PG8_SB(0, 1), b2 + hstep, voffB); PG8_STAGE_A(PG8_SA(0, 0), a2, 0, last);
            PG8_WAIT_V(8); PG8_WAIT_L(0); PG8_BAR; PG8_MMA(1, 0, At, B0); PG8_MMA(1, 1, At, B1); PG8_BAR; PG8_SCHED;
            PG8_LDB(B0, 1, 0); PG8_LDB(B1, 1, 1); PG8_SCHED; PG8_LDA(At, 1, 0); PG8_STAGE_A(PG8_SA(0, 1), a2, 1, last);
            PG8_WAIT_V(8); PG8_WAIT_L(0); PG8_BAR; PG8_MMA(0, 0, At, B0); PG8_MMA(0, 1, At, B1); PG8_BAR; PG8_SCHED;
            PG8_LDA(At, 1, 1); PG8_STAGE(PG8_SB(1, 0), b3, voffB); PG8_STAGE(PG8_SB(1, 1), b3 + hstep, voffB); PG8_STAGE_A(PG8_SA(1, 0), a3, 0, last);
            PG8_WAIT_V(8); PG8_WAIT_L(0); PG8_BAR; PG8_MMA(1, 0, At, B0); PG8_MMA(1, 1, At, B1); PG8_BAR; PG8_SCHED;
            } else {
            PG8_LDB(B0, 0, 0); PG8_SCHED; PG8_LDA(At, 0, 0); PG8_STAGE(PG8_SA(1, 1), a1 + hstep, voffA);
            PG8_WAIT_L(8); PG8_BAR; PG8_WAIT_L(0); PG8_MMA(0, 0, At, B0); PG8_BAR; PG8_SCHED;
            PG8_LDB(B1, 0, 1); PG8_STAGE(PG8_SB(0, 0), b2, voffB);
            PG8_BAR; PG8_WAIT_L(0); PG8_MMA(0, 1, At, B1); PG8_BAR;
            PG8_LDA(At, 0, 1); PG8_STAGE(PG8_SA(0, 0), a2, voffA);
            PG8_BAR; PG8_WAIT_L(0); PG8_MMA(1, 0, At, B0); PG8_BAR; PG8_SCHED;
            PG8_STAGE(PG8_SB(0, 1), b2 + hstep, voffB);
            PG8_WAIT_V(6); PG8_BAR; PG8_MMA(1, 1, At, B1); PG8_BAR;
            PG8_LDB(B0, 1, 0); PG8_SCHED; PG8_LDA(At, 1, 0); PG8_STAGE(PG8_SA(0, 1), a2 + hstep, voffA);
            PG8_WAIT_L(8); PG8_BAR; PG8_WAIT_L(0); PG8_MMA(0, 0, At, B0); PG8_BAR; PG8_SCHED;
            PG8_LDB(B1, 1, 1); PG8_STAGE(PG8_SB(1, 0), b3, voffB);
            PG8_BAR; PG8_WAIT_L(0); PG8_MMA(0, 1, At, B1); PG8_BAR;
            PG8_LDA(At, 1, 1); PG8_STAGE(PG8_SA(1, 0), a3, voffA);
            PG8_BAR; PG8_WAIT_L(0); PG8_MMA(1, 0, At, B0); PG8_BAR; PG8_SCHED;
            PG8_STAGE(PG8_SB(1, 1), b3 + hstep, voffB);
            PG8_WAIT_V(6); PG8_BAR; PG8_MMA(1, 1, At, B1); PG8_BAR;
            }
        }
        if constexpr (ALIGN_EPI) { if (wr == 0) PG8_BAR; }
        if constexpr (!Epi::AFTER_DRAIN) { E(acc, cur, wr, wc, fr, fq); S.done(cur); }
        if (!has_next) break;
#pragma unroll
        for (int a = 0; a < 2; ++a)
#pragma unroll
            for (int b = 0; b < 2; ++b)
#pragma unroll
                for (int m = 0; m < 4; ++m)
#pragma unroll
                    for (int n = 0; n < 2; ++n) acc[a][b][m][n] = (f32x4){0.f, 0.f, 0.f, 0.f};
        cur = nxt; cA = nA; cB = nB; ++ui;
        if constexpr (GATHER) { _Pragma("unroll") for (int h_ = 0; h_ < 2; ++h_) _Pragma("unroll") for (int i_ = 0; i_ < 2; ++i_) vAc[h_][i_] = vAn[h_][i_]; }
        if constexpr (ALIGN_EPI) { if (wr == 1) PG8_BAR; }
    }
    PG8_WAIT_V(0);
    if constexpr (!ALIGN_EPI) { if (wr == 0) PG8_BAR; }
    PG8_BAR;
    if constexpr (Epi::AFTER_DRAIN) { E.fused(acc, cur, wr, wc, fr, fq, lds, wid, lane); S.done(cur); }
#undef PG8_SA
#undef PG8_SB
#undef PG8_STAGE
#undef PG8_STAGE_A
#undef PG8_ROWS
#undef PG8_LDA
#undef PG8_LDB
#undef PG8_MMA
#undef PG8_WAIT_V
#undef PG8_WAIT_L
#undef PG8_BAR
#undef PG8_SCHED
}
}
namespace att {
typedef unsigned short bf16;
typedef short bf16x8 __attribute__((ext_vector_type(8)));
typedef short s16x4 __attribute__((ext_vector_type(4)));
typedef float f32x16 __attribute__((ext_vector_type(16)));
typedef float f32x4 __attribute__((ext_vector_type(4)));
typedef unsigned u32x4 __attribute__((ext_vector_type(4)));
typedef unsigned u32x2 __attribute__((ext_vector_type(2)));
#define ALAS __attribute__((address_space(3)))
constexpr int SEQ = 2048, NH = 16, DM = 1024, QB = 256, KVB = 64;
constexpr int SLOTB = 8192, L_K = 0, L_V = 2 * SLOTB, L_CB = 4 * SLOTB, L_WT = L_CB + SEQ * 4, L_ST = L_WT + 256, STG_ROW = 144, LDS_BYTES = L_ST + 8 * 32 * STG_ROW;
constexpr float C2 = 0.125f * 1.4426950408889634f;
__device__ __forceinline__ int crow(int r, int hi) { return (r & 3) + 8 * (r >> 2) + 4 * hi; }
__device__ __forceinline__ void glds16(const void* gsrc, unsigned lds_dst) { unsigned keep;
    asm volatile("s_mov_b32 %0, m0\n\ts_mov_b32 m0, %2\n\ts_nop 0\n\tglobal_load_lds_dwordx4 %1, off\n\ts_mov_b32 m0, %0" : "=&s"(keep) : "v"(gsrc), "s"(lds_dst) : "memory"); }
typedef float f32x2_t __attribute__((ext_vector_type(2))); typedef __bf16 bf16x2_t __attribute__((ext_vector_type(2)));
__device__ __forceinline__ unsigned cvtpk(float lo, float hi) { f32x2_t v = {lo, hi}; bf16x2_t b = __builtin_convertvector(v, bf16x2_t); return __builtin_bit_cast(unsigned, b); }
typedef short v4i16_t __attribute__((ext_vector_type(4)));
__device__ __forceinline__ s16x4 vtr(const ALAS char* p) { return __builtin_bit_cast(s16x4, __builtin_amdgcn_ds_read_tr16_b64_v4i16((ALAS v4i16_t*)p)); }
__device__ __forceinline__ float swap_other_mul(float x) { auto rr = __builtin_amdgcn_permlane32_swap(__float_as_uint(x), __float_as_uint(x), false, false); return __uint_as_float(rr[0]) * __uint_as_float(rr[1]); }

__device__ __forceinline__ void sb_wave_unit(int b, int h, int R0, const bf16* Q, const bf16* K, const bf16* V, bf16* O, ALAS char* wl) {
    int lane_ = threadIdx.x & 63; asm volatile("" : "+v"(lane_)); const int lane = lane_, r32 = lane & 31, hi = lane >> 5;
    const long rowbase = (long)b * SEQ;
    const bf16* Qw = Q + (rowbase + R0) * DM + h * 64;
    const bf16* Kh = K + rowbase * DM + h * 64; const bf16* Vh = V + rowbase * DM + h * 64;
    const unsigned lk = (unsigned)__builtin_amdgcn_readfirstlane((unsigned)(size_t)wl), lv = lk + 8192u;
    const int dkey = lane >> 3, dj = lane & 7;
#define SB_DMA_K(kb_) do { _Pragma("unroll") for (int p_ = 0; p_ < 8; ++p_) { const int kl_ = 8 * p_ + dkey; int key_ = (kb_) + kl_; key_ = key_ < 0 ? 0 : key_; \
        glds16(Kh + (long)key_ * DM + (dj ^ ((kl_ >> 1) & 7)) * 8, lk + p_ * 1024u); } } while (0)
#define SB_DMA_V(kb_) do { _Pragma("unroll") for (int p_ = 0; p_ < 8; ++p_) { const int kl_ = 8 * p_ + dkey; int key_ = (kb_) + kl_; key_ = key_ < 0 ? 0 : key_; \
        glds16(Vh + (long)key_ * DM + (dj ^ (4 * ((kl_ >> 1) & 1))) * 8, lv + p_ * 1024u); } } while (0)
    bf16x8 qr[4];
#pragma unroll
    for (int d0 = 0; d0 < 4; ++d0) qr[d0] = *reinterpret_cast<const bf16x8*>(&Qw[(long)r32 * DM + d0 * 16 + hi * 8]);
    int kb = R0 - 32;
    SB_DMA_K(kb); SB_DMA_V(kb);
    f32x16 o[2]; o[0] = f32x16{}; o[1] = f32x16{};
    float carry = 1.f;
    const int trow = R0 + r32;
    const ALAS char* kp = wl + r32 * 128; const int ksw = (r32 >> 1) & 7;
    int koff[4];
#pragma unroll
    for (int d0 = 0; d0 < 4; ++d0) koff[d0] = ((2 * d0 + hi) ^ ksw) * 16;
    const int vq = (lane & 15) >> 2, vpp = lane & 3, vsw = 4 * ((vq >> 1) & 1);
    const ALAS char* vpb[2];
#pragma unroll
    for (int d0 = 0; d0 < 2; ++d0) vpb[d0] = wl + 8192 + (4 * hi + vq) * 128 + (((4 * d0) ^ vsw) + 2 * ((lane >> 4) & 1) + (vpp >> 1)) * 16 + 8 * (vpp & 1);
    for (;;) {
        asm volatile("s_waitcnt vmcnt(8)" ::: "memory");
        f32x16 p0, p1;
#pragma unroll
        for (int d0 = 0; d0 < 4; ++d0) {
            const bf16x8 k0 = *(const ALAS bf16x8*)(kp + koff[d0]), k1 = *(const ALAS bf16x8*)(kp + koff[d0] + 4096);
            if (d0 == 0) { p0 = __builtin_amdgcn_mfma_f32_32x32x16_bf16(k0, qr[0], f32x16{}, 0, 0, 0); p1 = __builtin_amdgcn_mfma_f32_32x32x16_bf16(k1, qr[0], f32x16{}, 0, 0, 0); }
            else { p0 = __builtin_amdgcn_mfma_f32_32x32x16_bf16(k0, qr[d0], p0, 0, 0, 0); p1 = __builtin_amdgcn_mfma_f32_32x32x16_bf16(k1, qr[d0], p1, 0, 0, 0); }
        }
        const int kbn = kb - 64; const bool more = (kbn + 63 >= 0);
        asm volatile("s_waitcnt lgkmcnt(0)" ::: "memory");
        if (more) SB_DMA_K(kbn);
        f32x16 n0, n1;
#pragma unroll
        for (int r = 0; r < 16; ++r) {
            { const float z = __builtin_fmaxf(p0[r], -100.f), e = __builtin_amdgcn_exp2f(-z), rr = __builtin_amdgcn_rcpf(1.f + e); p0[r] = rr; n0[r] = e * rr; }
            { const float z = __builtin_fmaxf(p1[r], -100.f), e = __builtin_amdgcn_exp2f(-z), rr = __builtin_amdgcn_rcpf(1.f + e); p1[r] = rr; n1[r] = e * rr; }
        }
        if (kb + 63 >= R0 || kb < 0) {
#pragma unroll
            for (int r = 0; r < 16; ++r) { const int kv = kb + crow(r, hi);
                if (kv >= trow || kv < 0) { p0[r] = 0.f; n0[r] = 1.f; }
                if (kv + 32 >= trow || kv + 32 < 0) { p1[r] = 0.f; n1[r] = 1.f; } }
        }
        float G[8], i2[8], i1[8], i0[8];
#pragma unroll
        for (int g = 0; g < 4; ++g) { i2[g] = n0[4 * g + 3]; i1[g] = i2[g] * n0[4 * g + 2]; i0[g] = i1[g] * n0[4 * g + 1]; G[g] = i0[g] * n0[4 * g];
                                      i2[4 + g] = n1[4 * g + 3]; i1[4 + g] = i2[4 + g] * n1[4 * g + 2]; i0[4 + g] = i1[4 + g] * n1[4 * g + 1]; G[4 + g] = i0[4 + g] * n1[4 * g]; }
        float run = carry;
#pragma unroll
        for (int g = 7; g >= 0; --g) {
            auto rr = __builtin_amdgcn_permlane32_swap(__float_as_uint(G[g]), __float_as_uint(G[g]), false, false);
            const float other = hi ? 1.f : __uint_as_float(rr[1]);
            const float T = __uint_as_float(rr[0]) * __uint_as_float(rr[1]);
            const float af = run * other; run *= T;
            if (g < 4) { p0[4 * g + 3] *= af; p0[4 * g + 2] *= af * i2[g]; p0[4 * g + 1] *= af * i1[g]; p0[4 * g] *= af * i0[g]; }
            else { const int gg = g - 4; p1[4 * gg + 3] *= af; p1[4 * gg + 2] *= af * i2[g]; p1[4 * gg + 1] *= af * i1[g]; p1[4 * gg] *= af * i0[g]; }
        }
        carry = run;
        u32x4 pw[4];
#pragma unroll
        for (int j = 0; j < 4; ++j) { pw[0][j] = cvtpk(p0[2 * j], p0[2 * j + 1]); pw[1][j] = cvtpk(p0[8 + 2 * j], p0[8 + 2 * j + 1]); pw[2][j] = cvtpk(p1[2 * j], p1[2 * j + 1]); pw[3][j] = cvtpk(p1[8 + 2 * j], p1[8 + 2 * j + 1]); }
        if (more) asm volatile("s_waitcnt vmcnt(8)" ::: "memory"); else asm volatile("s_waitcnt vmcnt(0)" ::: "memory");
#pragma unroll
        for (int d0 = 0; d0 < 2; ++d0)
#pragma unroll
            for (int kq = 0; kq < 4; ++kq) { const s16x4 lo = vtr(vpb[d0] + kq * 2048), hh = vtr(vpb[d0] + kq * 2048 + 1024);
                const bf16x8 vf = (bf16x8){lo[0], lo[1], lo[2], lo[3], hh[0], hh[1], hh[2], hh[3]};
                o[d0] = __builtin_amdgcn_mfma_f32_32x32x16_bf16(vf, __builtin_bit_cast(bf16x8, pw[kq]), o[d0], 0, 0, 0); }
        if (!more || __all(carry == 0.f)) break;
        asm volatile("s_waitcnt lgkmcnt(0)" ::: "memory");
        SB_DMA_V(kbn);
        kb = kbn;
    }
    asm volatile("s_waitcnt vmcnt(0) lgkmcnt(0)" ::: "memory");
#undef SB_DMA_K
#undef SB_DMA_V
    ALAS char* stg = wl;
#pragma unroll
    for (int d0 = 0; d0 < 2; ++d0)
#pragma unroll
        for (int g = 0; g < 4; ++g) { u32x2 w; w.x = cvtpk(o[d0][4 * g], o[d0][4 * g + 1]); w.y = cvtpk(o[d0][4 * g + 2], o[d0][4 * g + 3]);
            *(ALAS u32x2*)(stg + r32 * STG_ROW + (32 * d0 + 8 * g + 4 * hi) * 2) = w; }
    asm volatile("s_waitcnt lgkmcnt(0)" ::: "memory");
    bf16* Ow = O + (rowbase + R0) * DM + h * 64;
#pragma unroll
    for (int i = 0; i < 4; ++i) { const int row = i * 8 + (lane >> 3), ch = lane & 7; const u32x4 v = *(const ALAS u32x4*)(stg + row * STG_ROW + ch * 16); *(u32x4*)(Ow + (long)row * DM + ch * 8) = v; }
    asm volatile("s_waitcnt vmcnt(0) lgkmcnt(0)" ::: "memory");
}
template <class Hook>
__device__ __forceinline__ void sb_phase(ALAS char* lds, int vcu, int G, const bf16* Q, const bf16* K, const bf16* V, bf16* O, Hook hook) {
    const int wid = __builtin_amdgcn_readfirstlane(threadIdx.x >> 6);
    int hi_ = 0;
    for (int v = vcu; v < 256; v += G) {
        const int bh = v >> 1, s = v & 1;
#pragma unroll 1
        for (int i = 0; i < 4; ++i) { const int qb = s ? (i == 0 ? 2 : i == 1 ? 5 : i == 2 ? 3 : 4) : (i == 0 ? 0 : i == 1 ? 7 : i == 2 ? 1 : 6);
            if (wid >= 4) hook(hi_, lds + wid * 16384);
            sb_wave_unit(bh / NH, bh % NH, qb * QB + wid * 32, Q, K, V, O, lds + wid * 16384);
            if (wid < 4) hook(hi_, lds + wid * 16384);
            ++hi_; }
    }
    for (; hi_ < 4; ++hi_) hook(hi_, lds + wid * 16384);
}
}
namespace fatt {
using bf16=__hip_bfloat16;
using bf16x8=__attribute__((ext_vector_type(8)))short;
using s16x4=__attribute__((ext_vector_type(4)))short;
using f32x16=__attribute__((ext_vector_type(16)))float;
using u32x4=__attribute__((ext_vector_type(4)))unsigned;
using f32x4v=__attribute__((ext_vector_type(4)))float;
constexpr int BATCH=8,NHEAD=16,SEQ=2048,D=64,DM=NHEAD*D;
constexpr int NW=8,QBLK=32,QB=QBLK*NW,KVBLK=64,NQB=SEQ/QB;
constexpr int ATTN_PITCH=DM, ATTN_UNIT_ROWS=QB;
__device__ __forceinline__ int crow(int r,int hi){return (r&3)+8*(r>>2)+4*hi;}
#define SBAR() __builtin_amdgcn_sched_barrier(0)
__device__ __forceinline__ void cmask(f32x16&p0,f32x16&p1,int jb,int qrel,int hi){
  const float NEG=-INFINITY; int kb=64*jb+4*hi;
  #pragma unroll
  for(int r=0;r<16;++r){int kv=kb+(r&3)+8*(r>>2); if(kv>qrel)p0[r]=NEG; if(kv+32>qrel)p1[r]=NEG;}
}

constexpr int NSLOT=3, SLOTB=8192;
constexpr int LDS_K=0, LDS_V=NSLOT*SLOTB, LDS_WS=2*NSLOT*SLOTB, LDS_OST=LDS_WS+NW*64*4, LDS_CB=LDS_OST+NW*4096, LDS_SC=LDS_CB+SEQ*4, LDS_BYTES=LDS_SC+64;
constexpr float C2=0.125f*1.4426950408889634f;
__device__ __forceinline__ void glds16(const void*gsrc,unsigned lds_dst){unsigned keep;
  asm volatile("s_mov_b32 %0, m0\n\ts_mov_b32 m0, %2\n\ts_nop 0\n\tglobal_load_lds_dwordx4 %1, off\n\ts_mov_b32 m0, %0":"=&s"(keep):"v"(gsrc),"s"(lds_dst):"memory");}
__device__ __forceinline__ float max3f(float a,float b,float c){float r;asm("v_max3_f32 %0, %1, %2, %3":"=v"(r):"v"(a),"v"(b),"v"(c));return r;}
__device__ __forceinline__ float max2f(float a,float b){float r;asm("v_max_f32_e32 %0, %1, %2":"=v"(r):"v"(a),"v"(b));return r;}
__device__ __forceinline__ float fadd_s(float a,float b){float r;asm("v_add_f32_e32 %0, %1, %2":"=v"(r):"v"(a),"v"(b));return r;}
__device__ __forceinline__ float fsub_s(float a,float b){float r;asm("v_sub_f32_e32 %0, %1, %2":"=v"(r):"v"(a),"v"(b));return r;}
typedef float f32x2_t __attribute__((ext_vector_type(2))); typedef __bf16 bf16x2_t __attribute__((ext_vector_type(2)));
__device__ __forceinline__ unsigned cvtpk_s(float lo,float hi){f32x2_t v={lo,hi};bf16x2_t b=__builtin_convertvector(v,bf16x2_t);return __builtin_bit_cast(unsigned,b);}
#define WAIT_BAR(N) asm volatile("s_waitcnt vmcnt(" #N ") lgkmcnt(0)\n\ts_barrier":::"memory")

__device__ __forceinline__ void qkt(f32x16&p0,f32x16&p1,const char*Kslot,const bf16x8*qr,int r32,int hi){
  const char*kb=Kslot+hi*1024+r32*16;
  #pragma unroll
  for(int d0=0;d0<4;++d0){
    const bf16x8 b0=*reinterpret_cast<const bf16x8*>(kb+d0*2048);
    const bf16x8 b1=*reinterpret_cast<const bf16x8*>(kb+d0*2048+512);
    p0=__builtin_amdgcn_mfma_f32_32x32x16_bf16(b0,qr[d0],p0,0,0,0);p1=__builtin_amdgcn_mfma_f32_32x32x16_bf16(b1,qr[d0],p1,0,0,0);}
}
typedef __attribute__((address_space(3))) const char* lds_cptr;
typedef short v4i16_t __attribute__((ext_vector_type(4)));
__device__ __forceinline__ void kload8(bf16x8*kf,lds_cptr kp){
  kf[0]=*(const __attribute__((address_space(3))) bf16x8*)(kp);      kf[1]=*(const __attribute__((address_space(3))) bf16x8*)(kp+512);
  kf[2]=*(const __attribute__((address_space(3))) bf16x8*)(kp+2048); kf[3]=*(const __attribute__((address_space(3))) bf16x8*)(kp+2560);
  kf[4]=*(const __attribute__((address_space(3))) bf16x8*)(kp+4096); kf[5]=*(const __attribute__((address_space(3))) bf16x8*)(kp+4608);
  kf[6]=*(const __attribute__((address_space(3))) bf16x8*)(kp+6144); kf[7]=*(const __attribute__((address_space(3))) bf16x8*)(kp+6656);
}
__device__ __forceinline__ void kload2(bf16x8*kf,lds_cptr kp,int j){ kf[2*j]=*(const __attribute__((address_space(3))) bf16x8*)(kp+j*2048); kf[2*j+1]=*(const __attribute__((address_space(3))) bf16x8*)(kp+j*2048+512); }
__device__ __forceinline__ s16x4 vtr(lds_cptr p){ return __builtin_bit_cast(s16x4,__builtin_amdgcn_ds_read_tr16_b64_v4i16((__attribute__((address_space(3))) v4i16_t*)p)); }
__device__ __forceinline__ float rowmax(const f32x16&p0,const f32x16&p1){
  float a=max3f(p0[0],p0[1],p1[0]),b=max3f(p0[2],p0[3],p1[1]);a=max3f(a,p1[2],p1[3]);
  #pragma unroll
  for(int r=4;r<16;r+=4){a=max3f(a,p0[r],p0[r+1]);b=max3f(b,p0[r+2],p0[r+3]);a=max3f(a,p1[r],p1[r+1]);b=max3f(b,p1[r+2],p1[r+3]);}
  const float m=max2f(a,b);
  auto rr=__builtin_amdgcn_permlane32_swap(__float_as_uint(m),__float_as_uint(m),false,false);
  return max2f(__uint_as_float(rr[0]),__uint_as_float(rr[1]));
}
__device__ __forceinline__ void pv(f32x16*o,int vb,bf16x8 pa0,bf16x8 pa1,bf16x8 pa2,bf16x8 pa3){
  #pragma unroll
  for(int d0=0;d0<2;++d0){s16x4 lo[4],hi[4];
    #pragma unroll
    for(int ks=0;ks<4;++ks){
      asm volatile("ds_read_b64_tr_b16 %0,%1 offset:%c2":"=&v"(lo[ks]):"v"(vb),"i"(d0*4096+ks*1024):"memory");
      asm volatile("ds_read_b64_tr_b16 %0,%1 offset:%c2":"=&v"(hi[ks]):"v"(vb),"i"(d0*4096+ks*1024+512):"memory");}
    asm volatile("s_waitcnt lgkmcnt(0)":::"memory");SBAR();
    #define PK(k) (bf16x8){lo[k][0],lo[k][1],lo[k][2],lo[k][3],hi[k][0],hi[k][1],hi[k][2],hi[k][3]}
    o[d0]=__builtin_amdgcn_mfma_f32_32x32x16_bf16(pa0,PK(0),o[d0],0,0,0);
    o[d0]=__builtin_amdgcn_mfma_f32_32x32x16_bf16(pa1,PK(1),o[d0],0,0,0);
    o[d0]=__builtin_amdgcn_mfma_f32_32x32x16_bf16(pa2,PK(2),o[d0],0,0,0);
    o[d0]=__builtin_amdgcn_mfma_f32_32x32x16_bf16(pa3,PK(3),o[d0],0,0,0);
    #undef PK
  }
}

#ifndef ATTN_STORE16
#define ATTN_STORE16(p,v) (*(u32x4*)(p)=(v))
#endif
template<int THRL> __device__ __forceinline__ void attn_unit(int b,int h,int qb,const bf16*Q,const bf16*__restrict__ K,const bf16*__restrict__ V,bf16*O,const float*logf,char*shm){
  int tid_=threadIdx.x; asm volatile("":"+v"(tid_));
  const int tid=tid_,lane=tid&63,r32=lane&31,hi=lane>>5; const int wid=__builtin_amdgcn_readfirstlane(tid>>6);
  const long rowbase=(long)b*SEQ; const int q0=qb*QB;
  const int NT=(q0+QB)/KVBLK;
  const bf16*Qw=Q+(rowbase+q0+wid*QBLK)*DM+h*D;
  const bf16*Kh=K+rowbase*DM+h*D,*Vh=V+rowbase*DM+h*D;
  const unsigned lds0=(unsigned)(uintptr_t)shm;
  float*wsf=(float*)(shm+LDS_WS)+wid*64;
  const bf16*ksrc=Kh+(long)lane*DM+wid*8;
  const bf16*vsrc=Vh+(long)(16*(wid&3)+(lane>>2))*DM+(wid>>2)*32+(lane&3)*8;
  const unsigned kdst=lds0+LDS_K+wid*1024, vdst=lds0+LDS_V+wid*1024;
  #define DMA_K(t,slot) glds16(ksrc+(long)(NT-1-(t))*KVBLK*DM,(unsigned)__builtin_amdgcn_readfirstlane(kdst+(slot)))
  #define DMA_V(t,slot) glds16(vsrc+(long)(NT-1-(t))*KVBLK*DM,(unsigned)__builtin_amdgcn_readfirstlane(vdst+(slot)))
  const int vb0=(int)(lds0+LDS_V)+((lane>>4)&1)*32+(lane&3)*8+(4*hi+((lane&15)>>2))*64;
  const char*Kbase=shm+LDS_K; bf16x8 kf[8];
  const lds_cptr shm3=(lds_cptr)shm; const lds_cptr kp0=shm3+LDS_K+hi*1024+r32*16; const lds_cptr vp0=shm3+LDS_V+((lane>>4)&1)*32+(lane&3)*8+(4*hi+((lane&15)>>2))*64;
  DMA_K(0,0);DMA_V(0,0);DMA_K(1,SLOTB);
  bf16x8 qr[4];
  #pragma unroll
  for(int d0=0;d0<4;++d0)qr[d0]=*reinterpret_cast<const bf16x8*>(&Qw[(long)r32*DM+d0*16+hi*8]);
  typedef __attribute__((address_space(3))) float* lds_fptr; typedef __attribute__((address_space(3))) f32x4v* lds_f4ptr;
  const lds_fptr cb3=(lds_fptr)(shm+LDS_CB);
  const float ct2=cb3[q0+wid*QBLK+r32];
  const int tstart=3-(wid>>1);
  #define BIAS(C0,C1,t) do{ const float cm_=ct2-mhat; const lds_f4ptr cp_=(lds_f4ptr)cb3+(((NT-1-(t))*KVBLK)>>2)+hi; \
    _Pragma("unroll") for(int g_=0;g_<4;++g_){ const f32x4v a_=cp_[2*g_], c_=cp_[8+2*g_]; \
      _Pragma("unroll") for(int j_=0;j_<4;++j_){ C0[4*g_+j_]=cm_-a_[j_]; C1[4*g_+j_]=cm_-c_[j_]; } } }while(0)
  float mhat=0.f,l_reg=0.f;f32x16 o[2];o[0]=f32x16{};o[1]=f32x16{};
  const int qrel=wid*QBLK+r32;
  #define CMASK(P0,P1,t) do{int jb_=3-(t); if(jb_>=0)cmask(P0,P1,jb_,qrel,hi);}while(0)
  bool resc=false;
  #define DECIDE(C0,C1,t,rm) do{ resc=false; const bool st_=((t)==tstart); \
    if(st_||__builtin_expect(__any((rm)>(float)THRL),0)){ const float dl=st_?(rm):__builtin_fmaxf((rm),0.f); mhat+=dl; \
      _Pragma("unroll") for(int r=0;r<16;++r){C0[r]-=dl;C1[r]-=dl;} \
      if(!st_){ const float f=__builtin_amdgcn_exp2f(-dl); l_reg*=f; if(hi==0)wsf[r32]=f; resc=true; } } }while(0)
  #define RESC() do{ if(resc){ asm volatile("s_waitcnt lgkmcnt(0)":::"memory"); \
      _Pragma("unroll") for(int d_=0;d_<2;++d_) _Pragma("unroll") for(int r=0;r<16;++r)o[d_][r]*=wsf[crow(r,hi)]; } }while(0)
  f32x16 pA0,pA1,pB0,pB1;
  int sl_prev=0,sl_cur=0,sl_next=SLOTB;
  #define ROT() do{sl_prev=sl_cur;sl_cur=sl_next;sl_next=(sl_next==(NSLOT-1)*SLOTB)?0:sl_next+SLOTB;}while(0)
  DMA_K(2,2*SLOTB);
  WAIT_BAR(3);
  BIAS(pA0,pA1,0);
  qkt(pA0,pA1,Kbase,qr,r32,hi);asm volatile("s_nop 15\n\ts_nop 7":"+v"(pA0),"+v"(pA1));CMASK(pA0,pA1,0);
  { const float rm0=rowmax(pA0,pA1); DECIDE(pA0,pA1,0,rm0); }
  BIAS(pB0,pB1,1);
  _Pragma("unroll") for(int r=0;r<16;++r){pA0[r]=__builtin_amdgcn_exp2f(pA0[r]);pA1[r]=__builtin_amdgcn_exp2f(pA1[r]);}
  WAIT_BAR(0);
  DMA_K(3,0);DMA_V(1,SLOTB);
  ROT();
  kload8(kf,kp0+sl_cur);
  WAIT_BAR(2);
  s16x4 vlo[8],vhi[8]; u32x4 pw0,pw1,pw2,pw3;
  #define PKW(P,B) cvtpk_s(P[B],P[B+1])
  #define PAF(k) __builtin_bit_cast(bf16x8,pw##k)
  #define VFR(i) (bf16x8){vlo[i][0],vlo[i][1],vlo[i][2],vlo[i][3],vhi[i][0],vhi[i][1],vhi[i][2],vhi[i][3]}
  #define PIN(x) asm volatile("":"+v"(x))
  #define MX3(a,b,c) __builtin_fmaxf(__builtin_fmaxf((a),(b)),(c))
  #define GAPA(MF,A0,A1,A2,A3,W0,W1,PW) do{ MF; sacc+=A0; sacc+=A1; sacc+=A2; sacc+=A3; PIN(sacc); W0; W1; PIN(PW); SBAR(); }while(0)
  #define EX(v) __builtin_amdgcn_exp2f(v)
  #define GAPB(MF,X,B,K_,TR,TW,GLF,PN0,PN1) do{ MF; X[B]=EX(X[B]); X[B+1]=EX(X[B+1]); X[B+2]=EX(X[B+2]); X[B+3]=EX(X[B+3]); PIN(X); \
    if(GLF){ if((K_)<7){TW=cp_[((K_)+1)<4?2*((K_)+1):8+2*((K_)-3)];} \
      if((K_)<4){ PN0[4*((K_)&3)]=cm_-TR[0]; PN0[4*((K_)&3)+1]=cm_-TR[1]; PN0[4*((K_)&3)+2]=cm_-TR[2]; PN0[4*((K_)&3)+3]=cm_-TR[3]; } \
      else { PN1[4*((K_)&3)]=cm_-TR[0]; PN1[4*((K_)&3)+1]=cm_-TR[1]; PN1[4*((K_)&3)+2]=cm_-TR[2]; PN1[4*((K_)&3)+3]=cm_-TR[3]; } } SBAR(); }while(0)
  #define VRD(i) do{ vlo[i]=vtr(vp_+(((i)>>2)*4096+((i)&3)*1024)); vhi[i]=vtr(vp_+(((i)>>2)*4096+((i)&3)*1024+512)); }while(0)
  #define KRD(G,j) do{ if(G){ kload2(kf,kp0+sl_next,j); SBAR(); } }while(0)
  #define STEP(C0,C1,P0,P1,t,GK,GV,GL) do{ SBAR(); \
    const lds_cptr vp_=vp0+sl_prev; \
    VRD(0); SBAR(); float sacc=(P0[0]+P0[1]); \
    GAPA(C0=__builtin_amdgcn_mfma_f32_32x32x16_bf16(kf[0],qr[0],C0,0,0,0), P0[2],P0[3],P0[4],P0[5],     pw0[0]=PKW(P0,0), pw0[1]=PKW(P0,2), pw0); \
    VRD(4); SBAR(); GAPA(C1=__builtin_amdgcn_mfma_f32_32x32x16_bf16(kf[1],qr[0],C1,0,0,0), P0[6],P0[7],P0[8],P0[9],     pw0[2]=PKW(P0,4), pw0[3]=PKW(P0,6), pw0); \
    VRD(1); SBAR(); GAPA(C0=__builtin_amdgcn_mfma_f32_32x32x16_bf16(kf[2],qr[1],C0,0,0,0),   P0[10],P0[11],P0[12],P0[13], pw1[0]=PKW(P0,8), pw1[1]=PKW(P0,10), pw1); \
    VRD(5); SBAR(); GAPA(C1=__builtin_amdgcn_mfma_f32_32x32x16_bf16(kf[3],qr[1],C1,0,0,0),   P0[14],P0[15],P1[0],P1[1],   pw1[2]=PKW(P0,12),pw1[3]=PKW(P0,14), pw1); \
    VRD(2); SBAR(); GAPA(C0=__builtin_amdgcn_mfma_f32_32x32x16_bf16(kf[4],qr[2],C0,0,0,0),   P1[2],P1[3],P1[4],P1[5],     pw2[0]=PKW(P1,0), pw2[1]=PKW(P1,2), pw2); \
    VRD(6); SBAR(); GAPA(C1=__builtin_amdgcn_mfma_f32_32x32x16_bf16(kf[5],qr[2],C1,0,0,0),   P1[6],P1[7],P1[8],P1[9],     pw2[2]=PKW(P1,4), pw2[3]=PKW(P1,6), pw2); \
    VRD(3); SBAR(); GAPA(C0=__builtin_amdgcn_mfma_f32_32x32x16_bf16(kf[6],qr[3],C0,0,0,0),   P1[10],P1[11],P1[12],P1[13], pw3[0]=PKW(P1,8), pw3[1]=PKW(P1,10), pw3); \
    VRD(7); SBAR(); GAPA(C1=__builtin_amdgcn_mfma_f32_32x32x16_bf16(kf[7],qr[3],C1,0,0,0),   P1[14],P1[15],0.f,0.f,       pw3[2]=PKW(P1,12),pw3[3]=PKW(P1,14), pw3); \
    l_reg+=sacc; \
    if(GK){DMA_K((t)+3,sl_cur);} if(GV){DMA_V((t)+1,sl_next);} \
    CMASK(C0,C1,t); \
    { float a=MX3(C0[0],C0[1],C1[0]),b=MX3(C0[2],C0[3],C1[1]); a=MX3(a,C1[2],C1[3]); \
      _Pragma("unroll") for(int r=4;r<16;r+=4){a=MX3(a,C0[r],C0[r+1]);b=MX3(b,C0[r+2],C0[r+3]);a=MX3(a,C1[r],C1[r+1]);b=MX3(b,C1[r+2],C1[r+3]);} \
      float rm=__builtin_fmaxf(a,b); { auto rr=__builtin_amdgcn_permlane32_swap(__float_as_uint(rm),__float_as_uint(rm),false,false); rm=__builtin_fmaxf(__uint_as_float(rr[0]),__uint_as_float(rr[1])); } \
      DECIDE(C0,C1,t,rm); } \
    const float cm_=ct2-mhat; const lds_f4ptr cp_=(lds_f4ptr)cb3+(((NT-2-(t))*KVBLK)>>2)+hi; f32x4v tbA=f32x4v{},tbB=f32x4v{}; if(GL){tbA=cp_[0];} \
    SBAR(); \
    GAPB(o[0]=__builtin_amdgcn_mfma_f32_32x32x16_bf16(PAF(0),VFR(0),o[0],0,0,0), C0,0, 0,tbA,tbB,GL,P0,P1); \
    GAPB(o[1]=__builtin_amdgcn_mfma_f32_32x32x16_bf16(PAF(0),VFR(4),o[1],0,0,0), C0,4, 1,tbB,tbA,GL,P0,P1); \
    KRD(GL,0); GAPB(o[0]=__builtin_amdgcn_mfma_f32_32x32x16_bf16(PAF(1),VFR(1),o[0],0,0,0), C0,8, 2,tbA,tbB,GL,P0,P1); \
    KRD(GL,1); GAPB(o[1]=__builtin_amdgcn_mfma_f32_32x32x16_bf16(PAF(1),VFR(5),o[1],0,0,0), C0,12, 3,tbB,tbA,GL,P0,P1); \
    KRD(GL,2); GAPB(o[0]=__builtin_amdgcn_mfma_f32_32x32x16_bf16(PAF(2),VFR(2),o[0],0,0,0), C1,0, 4,tbA,tbB,GL,P0,P1); \
    KRD(GL,3); GAPB(o[1]=__builtin_amdgcn_mfma_f32_32x32x16_bf16(PAF(2),VFR(6),o[1],0,0,0), C1,4, 5,tbB,tbA,GL,P0,P1); \
    GAPB(o[0]=__builtin_amdgcn_mfma_f32_32x32x16_bf16(PAF(3),VFR(3),o[0],0,0,0), C1,8, 6,tbA,tbB,GL,P0,P1); \
    GAPB(o[1]=__builtin_amdgcn_mfma_f32_32x32x16_bf16(PAF(3),VFR(7),o[1],0,0,0), C1,12, 7,tbB,tbA,GL,P0,P1); \
    }while(0)
  int t=1;
  for(;t+5<NT;t+=2){
    STEP(pB0,pB1,pA0,pA1,t,true,true,true);     WAIT_BAR(2); RESC(); ROT();
    STEP(pA0,pA1,pB0,pB1,t+1,true,true,true);   WAIT_BAR(2); RESC(); ROT();
  }
  #define ENDW(tt) do{ if((tt)+3<NT){WAIT_BAR(2);} else if((tt)+2<NT){WAIT_BAR(1);} else {WAIT_BAR(0);} }while(0)
  for(;t+1<NT;t+=2){
    STEP(pB0,pB1,pA0,pA1,t,(t+3<NT),(t+1<NT),(t+1<NT));       ENDW(t);   RESC(); ROT();
    STEP(pA0,pA1,pB0,pB1,t+1,(t+4<NT),(t+2<NT),(t+2<NT));     ENDW(t+1); RESC(); ROT();
  }
  STEP(pB0,pB1,pA0,pA1,NT-1,false,false,false); RESC();
  { float sacc=pB0[0]+pB0[1]; _Pragma("unroll") for(int r=2;r<16;++r)sacc+=pB0[r]; _Pragma("unroll") for(int r=0;r<16;++r)sacc+=pB1[r]; l_reg+=sacc;
    pw0=(u32x4){PKW(pB0,0),PKW(pB0,2),PKW(pB0,4),PKW(pB0,6)};pw1=(u32x4){PKW(pB0,8),PKW(pB0,10),PKW(pB0,12),PKW(pB0,14)};pw2=(u32x4){PKW(pB1,0),PKW(pB1,2),PKW(pB1,4),PKW(pB1,6)};pw3=(u32x4){PKW(pB1,8),PKW(pB1,10),PKW(pB1,12),PKW(pB1,14)};
    SBAR(); pv(o,vb0+sl_cur,PAF(0),PAF(1),PAF(2),PAF(3)); }
  #undef PKW
  #undef PAF
  #undef VFR
  #undef PIN
  #undef MX3
  #undef GAPA
  #undef GAPB
  #undef EX
  #undef VRD
  #undef KRD
  #undef STEP
  #undef ENDW
  {auto rr=__builtin_amdgcn_permlane32_swap(__float_as_uint(l_reg),__float_as_uint(l_reg),false,false);l_reg=__uint_as_float(rr[0])+__uint_as_float(rr[1]);}
  if(hi==0)wsf[32+r32]=l_reg;asm volatile("s_waitcnt lgkmcnt(0)":::"memory");
  float rli[16];
  #pragma unroll
  for(int r=0;r<16;++r)rli[r]=__builtin_amdgcn_rcpf(wsf[32+crow(r,hi)]);
  bf16*Ow=O+(rowbase+q0+wid*QBLK)*DM+h*D;
  { bf16*stg=(bf16*)(shm+LDS_OST)+wid*2048;
    #pragma unroll
    for(int r=0;r<16;++r){const int orow=crow(r,hi);
      #pragma unroll
      for(int d0=0;d0<2;++d0)stg[orow*64+d0*32+r32]=__float2bfloat16(o[d0][r]*rli[r]);}
    asm volatile("s_waitcnt lgkmcnt(0)":::"memory");
    #pragma unroll
    for(int i=0;i<4;++i){const int row=i*8+(lane>>3),ch=lane&7; const u32x4 v=*(const u32x4*)(stg+row*64+ch*8); ATTN_STORE16(Ow+(long)row*DM+ch*8,v);} }
  asm volatile("s_waitcnt lgkmcnt(0)\n\ts_barrier":::"memory");
  #undef DMA_K
  #undef DMA_V
  #undef CMASK
  #undef DECIDE
  #undef BIAS
  #undef RESC
  #undef ROT
}
constexpr int ATTN_LDS_BYTES=LDS_BYTES;
template<int THRL=8> __device__ __forceinline__ void attn_phase(char*lds,int vcu,int G,const bf16*Q,const bf16*K,const bf16*V,bf16*O,const float*logf){
  for(int v=vcu;v<BATCH*NHEAD*2;v+=G){ const int bh=v>>1,s_=v&1;
    {
      typedef __attribute__((address_space(3))) float* lds_fptr; typedef __attribute__((address_space(3))) f32x4v* lds_f4ptr;
      char*shm=lds; const int tid=threadIdx.x,lane=tid&63; const int wid=__builtin_amdgcn_readfirstlane(tid>>6); const int h=bh%NHEAD; const long rowbase=(long)(bh/NHEAD)*SEQ;
      const lds_fptr cb3=(lds_fptr)(shm+LDS_CB); const lds_fptr sc3=(lds_fptr)(shm+LDS_SC);
      asm volatile("s_waitcnt lgkmcnt(0)\n\ts_barrier":::"memory");
      float v0=logf[(rowbase+4*tid+0)*NHEAD+h],v1=logf[(rowbase+4*tid+1)*NHEAD+h],v2=logf[(rowbase+4*tid+2)*NHEAD+h],v3=logf[(rowbase+4*tid+3)*NHEAD+h];
      v1+=v0;v2+=v1;v3+=v2; float x=v3;
      #pragma unroll
      for(int off=1;off<64;off<<=1){const float n_=__shfl_up(x,off); if(lane>=off)x+=n_;}
      if(lane==63)sc3[wid]=x;
      asm volatile("s_waitcnt lgkmcnt(0)\n\ts_barrier":::"memory");
      float pre=x-v3; for(int w2=0;w2<wid;++w2)pre+=sc3[w2];
      const float L2E=1.4426950408889634f;
      *(lds_f4ptr)(cb3+4*tid)=(f32x4v){(pre+v0)*L2E,(pre+v1)*L2E,(pre+v2)*L2E,(pre+v3)*L2E};
      asm volatile("s_waitcnt lgkmcnt(0)\n\ts_barrier":::"memory"); }
    #pragma unroll 1
    for(int i=0;i<4;++i){ const int qb=s_?(i==0?2:i==1?5:i==2?3:4):(i==0?0:i==1?7:i==2?1:6);
      attn_unit<THRL>(bh/NHEAD,bh%NHEAD,qb,Q,K,V,O,logf,lds); } }
}
#undef SBAR
#undef WAIT_BAR
}

constexpr int NWAVES = 8;
constexpr int BATCH = 8, SEQ = 2048, D = 1024, NH = 16, NE = 16, FE = 512, M = BATCH * SEQ;
constexpr int SLOTS = 2 * M + NE * 256;
constexpr float RMS_EPS = 1e-6f;
constexpr size_t MiB = 1u << 20;
constexpr size_t WS_CTL = 0, CTL_ZERO_BYTES = 64 * 1024;
constexpr size_t WS_RSTD = 1 * MiB;
constexpr size_t WS_ROUTE = 2 * MiB;
constexpr size_t WS_LOGF = 3 * MiB;
constexpr size_t WS_WQKV = 8 * MiB, WS_WOA = 14 * MiB, WS_WKVQ = 16 * MiB, WS_WOB = 22 * MiB;
constexpr size_t WS_WGU = 24 * MiB;
constexpr size_t WS_WD = 88 * MiB;
constexpr size_t WS_Q = 120 * MiB, WS_K = 152 * MiB, WS_V = 184 * MiB, WS_XB = 216 * MiB;
constexpr size_t WS_Y = 120 * MiB;
constexpr size_t WS_HS = 248 * MiB;
constexpr size_t WS_ROWTAB = 4 * MiB;
constexpr size_t WS_END = 284 * MiB;
static_assert(WS_Y + (size_t)SLOTS * D * 2 <= WS_XB && WS_HS + (size_t)SLOTS * FE * 2 <= WS_END, "ws map");
constexpr int CW_CNT = 64;
constexpr int CW_BAR = 4096;
constexpr int ROWIDX_OFF = 131072, RSTAB_OFF = 131072 + 3072;
constexpr int RING_BYTES = 131072, LDSCTL_OFF = 139264, MISC_OFF = LDSCTL_OFF + 320, LDS_BYTES = 147456;
constexpr int NPH = 17;

#define GAS __attribute__((address_space(1)))
#define LAS __attribute__((address_space(3)))
typedef unsigned short bf16;
typedef unsigned v4u __attribute__((ext_vector_type(4)));
typedef float f32x4 __attribute__((ext_vector_type(4)));
typedef short bf16x8 __attribute__((ext_vector_type(8)));
typedef GAS unsigned gu32;
typedef GAS unsigned long long gu64;
#define RLX_AGENT __ATOMIC_RELAXED, __HIP_MEMORY_SCOPE_AGENT
#define LDS_WAIT() asm volatile("s_waitcnt lgkmcnt(0)" ::: "memory")
#define VM_WAIT() asm volatile("s_waitcnt vmcnt(0)" ::: "memory")
__device__ __forceinline__ unsigned long long rt() { return __builtin_amdgcn_s_memrealtime(); }
__device__ __forceinline__ unsigned f2bf(float f) { unsigned u = __builtin_bit_cast(unsigned, f); return (u + 0x7fffu + ((u >> 16) & 1u)) >> 16; }
__device__ __forceinline__ unsigned pk2(float lo, float hi) { return f2bf(lo) | (f2bf(hi) << 16); }

#define XB_TMO      128
#define XB_XCNT(j)  (256  + 64 * (j))
#define XB_XSUB(j)  (1280 + 64 * (j))
#define XB_XGEN(j)  (2304 + 64 * (j))
#define XB_TOP      3328
#define XB_TOPGEN   3392
#define XCD_BAR_WORDS 3456
#define XB_SPIN_CAP (1u << 18)

__device__ __forceinline__ unsigned xb_ld(unsigned* p)              { return __hip_atomic_load(p, __ATOMIC_RELAXED, __HIP_MEMORY_SCOPE_AGENT); }
__device__ __forceinline__ unsigned xb_add(unsigned* p, unsigned v) { return __hip_atomic_fetch_add(p, v, __ATOMIC_RELAXED, __HIP_MEMORY_SCOPE_AGENT); }
__device__ __forceinline__ unsigned xb_xcc_id() { return (unsigned)__builtin_amdgcn_s_getreg((3 << 11) | 20) & 0xFu; }
#define XB_SPIN(cond, bar) do { unsigned _sp = 0; while (cond) { __builtin_amdgcn_s_sleep(1); \
    if ((++_sp & 255u) == 0u) { if (xb_ld(&(bar)[XB_TMO])) break; if (_sp > XB_SPIN_CAP) { atomicAdd(&(bar)[XB_TMO], 1u); break; } } } } while (0)

struct XcdBarrier {
    unsigned* bar; unsigned x;
    volatile LAS unsigned* st;
};

__device__ __forceinline__ XcdBarrier xcd_barrier_post(unsigned* bar, volatile LAS unsigned* st) {
    XcdBarrier b; b.bar = bar; b.x = xb_xcc_id(); b.st = st;
    if (threadIdx.x == 0) (void)xb_add(&bar[XB_XCNT(b.x)], 1u);
    return b;
}
__device__ __forceinline__ void xcd_barrier_complete(unsigned* bar, unsigned x, unsigned& nloc, unsigned& nx) {
    const unsigned G = gridDim.x * gridDim.y * gridDim.z;
    unsigned sum, cnt, mine, sp = 0u;
    for (;;) {
        sum = 0u; cnt = 0u; mine = 0u;
#pragma unroll
        for (unsigned j = 0; j < 16; ++j) { const unsigned c = xb_ld(&bar[XB_XCNT(j)]); sum += c; cnt += (c > 0u) ? 1u : 0u; mine = (j == x) ? c : mine; }
        if (sum == G) break;
        __builtin_amdgcn_s_sleep(1);
        if ((++sp & 255u) == 0u) { if (xb_ld(&bar[XB_TMO])) break; if (sp > XB_SPIN_CAP) { atomicAdd(&bar[XB_TMO], 1u); break; } }
    }
    nloc = mine > 0u ? mine : 1u; nx = cnt > 0u ? cnt : 1u;
}

struct NoShadow { __device__ __forceinline__ void operator()() const {} };
template <class Shadow = NoShadow>
__device__ __forceinline__ void xcd_barrier(const XcdBarrier& b, const Shadow& shadow = Shadow()) {
    asm volatile("s_waitcnt vmcnt(0)" ::: "memory");
    __syncthreads();
    if (threadIdx.x >= 64) { shadow(); asm volatile("s_waitcnt vmcnt(0)" ::: "memory"); }
    if (threadIdx.x == 0) {
        unsigned* bar = b.bar;
        __builtin_amdgcn_s_waitcnt(0);
        unsigned nloc = b.st[0], nx = b.st[1];
        if (nloc == 0u) { xcd_barrier_complete(bar, b.x, nloc, nx); b.st[0] = nloc; b.st[1] = nx; }
        const unsigned old = xb_add(&bar[XB_XSUB(b.x)], 1u);
        const unsigned gen = old / nloc;
        if (old + 1u == (gen + 1u) * nloc) {
            __builtin_amdgcn_fence(__ATOMIC_RELEASE, "agent");
            asm volatile("s_waitcnt vmcnt(0)" ::: "memory");
            const unsigned og = xb_add(&bar[XB_TOP], 1u);
            const unsigned tg = og / nx;
            if (og + 1u == (tg + 1u) * nx) xb_add(&bar[XB_TOPGEN], 1u);
            else XB_SPIN(xb_ld(&bar[XB_TOPGEN]) == tg, bar);
            __builtin_amdgcn_fence(__ATOMIC_ACQUIRE, "agent");
            xb_add(&bar[XB_XGEN(b.x)], 1u);
            asm volatile("s_waitcnt vmcnt(0)" ::: "memory");
        } else {
            XB_SPIN(xb_ld(&bar[XB_XGEN(b.x)]) == gen, bar);
            __builtin_amdgcn_fence(__ATOMIC_ACQUIRE, "agent");
            asm volatile("s_waitcnt vmcnt(0)" ::: "memory");
        }
    }
    __syncthreads();
}

struct Frame {
    LAS unsigned char* lds; volatile LAS unsigned* MISC; gu32* ctl;
    int tid, lane, wave, vcu, G;
};
__device__ __forceinline__ float wave_sum(float v) {
#pragma unroll
    for (int o = 1; o < 64; o <<= 1) v += __shfl_xor(v, o);
    return v;
}
__device__ __forceinline__ unsigned ldu(const unsigned* p) { return __hip_atomic_load(p, __ATOMIC_RELAXED, __HIP_MEMORY_SCOPE_AGENT); }
__device__ __forceinline__ unsigned cvtpk2(float lo, float hi) { typedef float f2 __attribute__((ext_vector_type(2))); typedef __bf16 b2 __attribute__((ext_vector_type(2))); f2 v = {lo, hi}; b2 b = __builtin_convertvector(v, b2); return __builtin_bit_cast(unsigned, b); }
__device__ __forceinline__ float bflo(unsigned w) { return __uint_as_float(w << 16); }
__device__ __forceinline__ float bfhi(unsigned w) { return __uint_as_float(w & 0xffff0000u); }

struct TItem { const float* W; const float* gain; bf16* WT; int ldw, K, k0, n0, dst_row0; const float* dummy; };
__device__ __forceinline__ void titem_load(const TItem& t, int lane, f32x4 (&v)[16], float (&g)[16]) {
    const int kq = lane >> 4, c4 = (lane & 15) * 4;
#pragma unroll
    for (int i = 0; i < 16; ++i) { const int kk = 4 * i + kq; v[i] = __builtin_nontemporal_load((const GAS f32x4*)(t.W + (size_t)(t.k0 + kk) * t.ldw + t.n0 + c4)); { const float gl_ = (t.gain ? t.gain : t.dummy)[(t.k0 + kk) & 1023]; g[i] = t.gain ? gl_ : 1.f; } }
}
__device__ __forceinline__ void titem_store(const TItem& t, int lane, const f32x4 (&v)[16], const float (&g)[16], LAS float* scr) {
    const int kq = lane >> 4, c4 = (lane & 15) * 4;
#pragma unroll
    for (int i = 0; i < 16; ++i) { const int kk = 4 * i + kq; const f32x4 x = v[i] * g[i]; LAS float* s = scr + kk * 65 + c4; s[0] = x.x; s[1] = x.y; s[2] = x.z; s[3] = x.w; }
    LDS_WAIT(); asm volatile("" ::: "memory");
    const int c = 4 * (lane >> 5) + ((lane >> 3) & 3), nl = lane & 7;
#pragma unroll
    for (int j = 0; j < 8; ++j) { const int n = 8 * j + nl; const LAS float* s = scr + (8 * c) * 65 + n;
        v4u o; o.x = cvtpk2(s[0], s[65]); o.y = cvtpk2(s[2 * 65], s[3 * 65]); o.z = cvtpk2(s[4 * 65], s[5 * 65]); o.w = cvtpk2(s[6 * 65], s[7 * 65]);
        *(GAS v4u*)(t.WT + (size_t)(t.dst_row0 + n) * t.K + t.k0 + 8 * c) = o; }
    LDS_WAIT(); asm volatile("" ::: "memory");
}
__device__ __forceinline__ void titem32_load(const TItem& t, int lane, f32x4 (&v)[8], float (&g)[8]) {
    const int rq = lane >> 3, c4 = (lane & 7) * 4;
#pragma unroll
    for (int i = 0; i < 8; ++i) { const int kk = 8 * i + rq; v[i] = __builtin_nontemporal_load((const GAS f32x4*)(t.W + (size_t)(t.k0 + kk) * t.ldw + t.n0 + c4)); { const float gl_ = (t.gain ? t.gain : t.dummy)[(t.k0 + kk) & 1023]; g[i] = t.gain ? gl_ : 1.f; } }
}
__device__ __forceinline__ void titem32_store(const TItem& t, int lane, const f32x4 (&v)[8], const float (&g)[8], LAS float* scr) {
    const int rq = lane >> 3, c4 = (lane & 7) * 4;
#pragma unroll
    for (int i = 0; i < 8; ++i) { const int kk = 8 * i + rq; const f32x4 x = v[i] * g[i]; LAS float* s = scr + kk * 33 + c4; s[0] = x.x; s[1] = x.y; s[2] = x.z; s[3] = x.w; }
    LDS_WAIT(); asm volatile("" ::: "memory");
    const int c = 4 * (lane >> 5) + ((lane >> 3) & 3), nl = lane & 7;
#pragma unroll
    for (int j = 0; j < 4; ++j) { const int n = 8 * j + nl; const LAS float* s = scr + (8 * c) * 33 + n;
        v4u o; o.x = cvtpk2(s[0], s[33]); o.y = cvtpk2(s[2 * 33], s[3 * 33]); o.z = cvtpk2(s[4 * 33], s[5 * 33]); o.w = cvtpk2(s[6 * 33], s[7 * 33]);
        *(GAS v4u*)(t.WT + (size_t)(t.dst_row0 + n) * t.K + t.k0 + 8 * c) = o; }
    LDS_WAIT(); asm volatile("" ::: "memory");
}
struct In {
    const float *x, *attn_norm, *w_qkv_a, *w_o_a, *kv_norm, *w_kvf, *b_f, *w_q_b, *w_o_b, *moe_norm, *w_group, *w_router, *w_gate, *w_up, *w_down, *final_norm;
};
__device__ __forceinline__ void p0_prologue(Frame& F, const In& I, unsigned char* ws) {
    int tid_ = threadIdx.x; asm volatile("" : "+v"(tid_));
    const int lane = tid_ & 63, wave = __builtin_amdgcn_readfirstlane(tid_ >> 6);
    LAS float* scr = (LAS float*)(F.lds + wave * 16640);
    const int gw = F.vcu * NWAVES + wave, NGW = F.G * NWAVES;
    bf16* Wqkv = (bf16*)(ws + WS_WQKV); bf16* Woa = (bf16*)(ws + WS_WOA); bf16* Wkvq = (bf16*)(ws + WS_WKVQ); bf16* Wob = (bf16*)(ws + WS_WOB);
    bf16* Wgu = (bf16*)(ws + WS_WGU); bf16* Wd = (bf16*)(ws + WS_WD);
    constexpr int NITEMS = 16 * 48;
    auto decode = [&](int r) -> TItem { return TItem{I.w_qkv_a, I.attn_norm, Wqkv, 3072, 1024, 64 * (r / 48), 64 * (r % 48), 64 * (r % 48), I.attn_norm}; };
    {
        f32x4 nv[16]; float ng[16]; int it = gw; TItem cur{};
        if (it < NITEMS) { cur = decode(it); titem_load(cur, lane, nv, ng); }
        for (; it < NITEMS; it += NGW) {
            f32x4 v[16]; float g[16];
#pragma unroll
            for (int i = 0; i < 16; ++i) { v[i] = nv[i]; g[i] = ng[i]; }
            const TItem me = cur;
            if (it + NGW < NITEMS) { cur = decode(it + NGW); titem_load(cur, lane, nv, ng); }
            titem_store(me, lane, v, g, scr);
        }
    }
    bf16* XB = (bf16*)(ws + WS_XB); float* rstd = (float*)(ws + WS_RSTD);
    {
        f32x4 na[4], nb[4]; int m = gw;
#define P0_LD(dst, m_) do { const GAS f32x4* xr_ = (const GAS f32x4*)(I.x + (size_t)((m_) < M ? (m_) : gw) * D) + lane; _Pragma("unroll") for (int j = 0; j < 4; ++j) dst[j] = __builtin_nontemporal_load(xr_ + 64 * j); } while (0)
#define P0_ST(v, m_) do { if ((m_) < M) { float s_ = 0.f; _Pragma("unroll") for (int j = 0; j < 4; ++j) s_ += (v[j].x * v[j].x + v[j].y * v[j].y) + (v[j].z * v[j].z + v[j].w * v[j].w); \
            s_ = wave_sum(s_); GAS unsigned long long* o8_ = (GAS unsigned long long*)(XB + (size_t)(m_) * D) + lane; \
            _Pragma("unroll") for (int j = 0; j < 4; ++j) o8_[64 * j] = (unsigned long long)cvtpk2(v[j].x, v[j].y) | ((unsigned long long)cvtpk2(v[j].z, v[j].w) << 32); \
            if (lane == 0) rstd[m_] = 1.f / sqrtf(s_ * (1.f / D) + RMS_EPS); } } while (0)
        P0_LD(na, m); P0_LD(nb, m + NGW);
        for (; m < M; m += 2 * NGW) {
            f32x4 va[4], vb[4];
#pragma unroll
            for (int j = 0; j < 4; ++j) { va[j] = na[j]; vb[j] = nb[j]; }
            P0_LD(na, m + 2 * NGW); P0_LD(nb, m + 3 * NGW);
            P0_ST(va, m); P0_ST(vb, m + NGW);
        }
#undef P0_LD
#undef P0_ST
    }
}

__device__ __forceinline__ TItem dense_item(const In& I, unsigned char* ws, int r) {
    bf16* Woa = (bf16*)(ws + WS_WOA); bf16* Wkvq = (bf16*)(ws + WS_WKVQ); bf16* Wob = (bf16*)(ws + WS_WOB);
    constexpr int J_SQ = 16 * 32, J_KV = 16 * 64;
    if (r < J_SQ) return TItem{I.w_o_a, nullptr, Woa, 1024, 1024, 64 * (r / 32), 32 * (r % 32), 32 * (r % 32), I.attn_norm}; r -= J_SQ;
    if (r < J_KV) return TItem{I.w_kvf, I.kv_norm, Wkvq, 2064, 1024, 64 * (r / 64), 32 * (r % 64), 32 * (r % 64), I.attn_norm}; r -= J_KV;
    if (r < J_SQ) return TItem{I.w_q_b, I.attn_norm + 1024, Wkvq, 1024, 1024, 64 * (r / 32), 32 * (r % 32), 2048 + 32 * (r % 32), I.attn_norm}; r -= J_SQ;
    return TItem{I.w_o_b, nullptr, Wob, 1024, 1024, 64 * (r / 32), 32 * (r % 32), 32 * (r % 32), I.attn_norm};
}
__device__ __forceinline__ TItem expert_item(const In& I, unsigned char* ws, int l, int r) {
    bf16* Wgu = (bf16*)(ws + WS_WGU); bf16* Wd = (bf16*)(ws + WS_WD);
    const int kind = r >> 12, q = r & 4095, le = l * 16 + (q >> 8), q2 = q & 255;
    if (kind < 2) { const int kb = q2 >> 4, nb = q2 & 15, f0 = 32 * nb;
        return TItem{(kind ? I.w_up : I.w_gate) + (size_t)le * 1024 * 512, I.moe_norm + l * 1024, Wgu + (size_t)le * 1024 * 1024, 512, 1024, 64 * kb, f0, 256 * (f0 >> 7) + 128 * kind + (f0 & 127), I.attn_norm}; }
    { const int kb = q2 >> 5, nb = q2 & 31;
      return TItem{I.w_down + (size_t)le * 512 * 1024, nullptr, Wd + (size_t)le * 1024 * 512, 1024, 512, 64 * kb, 32 * nb, 32 * nb, I.attn_norm}; }
}
constexpr int DENSE_ITEMS = 3 * 16 * 32 + 16 * 64, DENSE_L0 = 16 * 32, EXPERT_ITEMS = 3 * 16 * 256;
constexpr int DEFERRED_ITEMS = 0;
constexpr int TAIL_DN0 = 16 * 256 - 7 * 256;
constexpr int TAIL_ITEMS = TAIL_DN0 + EXPERT_ITEMS + (DENSE_ITEMS - DENSE_L0);
constexpr int SHADOW_PER_BAR = 7 * 256, SHADOW_GU = 4 * SHADOW_PER_BAR - DENSE_L0, SHADOW_DN = SHADOW_PER_BAR, SHADOW_ITEMS = 5 * SHADOW_PER_BAR;
constexpr int GU_ITEMS = 2 * 16 * 256, DN_ITEMS = 16 * 256;
__device__ __forceinline__ TItem shadow_decode(const In& I, unsigned char* ws, int r) {
    if (r < DENSE_L0) return dense_item(I, ws, r); r -= DENSE_L0; if (r < SHADOW_GU) return expert_item(I, ws, 0, r); r -= SHADOW_GU; return expert_item(I, ws, 0, GU_ITEMS + r); }
__device__ __forceinline__ TItem deferred_decode(const In& I, unsigned char* ws, int r) { return expert_item(I, ws, 0, GU_ITEMS + SHADOW_DN + r); }
constexpr int ROUTER_IDLE_ITEMS = 2 * 16 * 256 - (4 * 7 * 256 - 16 * 32);
__device__ __forceinline__ TItem tail_decode(const In& I, unsigned char* ws, int r) {
    if (r < TAIL_DN0) return expert_item(I, ws, 0, 2 * 16 * 256 + 7 * 256 + r); r -= TAIL_DN0;
    if (r < DENSE_ITEMS - DENSE_L0) return dense_item(I, ws, DENSE_L0 + r); return expert_item(I, ws, 1, r - (DENSE_ITEMS - DENSE_L0)); }
constexpr int TAIL_G3 = 6 * 1792, TAIL_G4 = TAIL_G3 + 2 * 1792;
__device__ __forceinline__ void tail_items(const In& I, unsigned char* ws, int slot, int nslots, int lo, int hi, LAS float* scr) {
    int lane_ = threadIdx.x & 63; asm volatile("" : "+v"(lane_)); const int lane = lane_;
    f32x4 nv[8]; float ng[8]; TItem cur{}; int it = lo + slot;
    if (it < hi) { cur = tail_decode(I, ws, it); titem32_load(cur, lane, nv, ng); }
    for (; it < hi; it += nslots) {
        f32x4 v[8]; float g[8];
#pragma unroll
        for (int i = 0; i < 8; ++i) { v[i] = nv[i]; g[i] = ng[i]; }
        const TItem me = cur;
        if (it + nslots < hi) { cur = tail_decode(I, ws, it + nslots); titem32_load(cur, lane, nv, ng); }
        titem32_store(me, lane, v, g, scr);
    }
}
__device__ __forceinline__ void deferred_items(const In& I, unsigned char* ws, int gw, int NGW, int round, LAS float* scr) {
    int lane_ = threadIdx.x & 63; asm volatile("" : "+v"(lane_)); const int lane = lane_;
    const int jmax = (DEFERRED_ITEMS + NGW - 1) / NGW;
    int j = 4 * round; const int jend = (round == 3) ? jmax : (4 * round + 4 < jmax ? 4 * round + 4 : jmax);
    f32x4 nv[8]; float ng[8]; TItem cur{};
    if (j < jend && gw + NGW * j < DEFERRED_ITEMS) { cur = deferred_decode(I, ws, gw + NGW * j); titem32_load(cur, lane, nv, ng); }
    for (; j < jend && gw + NGW * j < DEFERRED_ITEMS; ++j) {
        f32x4 v[8]; float g[8];
#pragma unroll
        for (int i = 0; i < 8; ++i) { v[i] = nv[i]; g[i] = ng[i]; }
        const TItem me = cur;
        if (j + 1 < jend && gw + NGW * (j + 1) < DEFERRED_ITEMS) { cur = deferred_decode(I, ws, gw + NGW * (j + 1)); titem32_load(cur, lane, nv, ng); }
        titem32_store(me, lane, v, g, scr);
    }
}

typedef float f32x16 __attribute__((ext_vector_type(16)));
typedef unsigned u32x4v __attribute__((ext_vector_type(4)));
constexpr int DOT_STRIDE = 36, DOT_TILE_BYTES = 64 * DOT_STRIDE * 4, RED_STRIDE = 33;
typedef short bfx8 __attribute__((ext_vector_type(8)));
__device__ __forceinline__ void split2(float x0, float x1, unsigned& hi, unsigned& lo) {
    hi = cvtpk2(x0, x1); lo = cvtpk2(x0 - __uint_as_float(hi << 16), x1 - __uint_as_float(hi & 0xffff0000u));
}
template <bool A_BF16 = false>
__device__ __forceinline__ void rowdots_chunk_mfma(const LAS float* tile, int lane, const u32x4v (&bh)[2], const u32x4v (&bl)[2], f32x16 (&acc)[2], float (&ss)[2]) {
#pragma unroll
    for (int rb = 0; rb < 2; ++rb)
#pragma unroll
        for (int st = 0; st < 2; ++st) { const LAS f32x4* ap = (const LAS f32x4*)(tile + (32 * rb + (lane & 31)) * DOT_STRIDE + 16 * st + 8 * (lane >> 5));
            const f32x4 a0 = ap[0], a1 = ap[1];
            ss[rb] += (a0.x * a0.x + a0.y * a0.y) + (a0.z * a0.z + a0.w * a0.w) + (a1.x * a1.x + a1.y * a1.y) + (a1.z * a1.z + a1.w * a1.w);
            u32x4v ah, al; { unsigned h_, l_; split2(a0.x, a0.y, h_, l_); ah.x = h_; al.x = l_; } { unsigned h_, l_; split2(a0.z, a0.w, h_, l_); ah.y = h_; al.y = l_; } { unsigned h_, l_; split2(a1.x, a1.y, h_, l_); ah.z = h_; al.z = l_; } { unsigned h_, l_; split2(a1.z, a1.w, h_, l_); ah.w = h_; al.w = l_; }
            const bfx8 Ah = __builtin_bit_cast(bfx8, ah), Al = __builtin_bit_cast(bfx8, al), Bh = __builtin_bit_cast(bfx8, bh[st]), Bl = __builtin_bit_cast(bfx8, bl[st]);
            acc[rb] = __builtin_amdgcn_mfma_f32_32x32x16_bf16(Ah, Bh, acc[rb], 0, 0, 0);
            acc[rb] = __builtin_amdgcn_mfma_f32_32x32x16_bf16(Ah, Bl, acc[rb], 0, 0, 0);
            if (!A_BF16) acc[rb] = __builtin_amdgcn_mfma_f32_32x32x16_bf16(Al, Bh, acc[rb], 0, 0, 0); }
}
__device__ __forceinline__ void rowdots_publish(LAS float* red, LAS float* sst, int wave, int lane, const f32x16 (&acc)[2], const float (&ss)[2]) {
#pragma unroll
    for (int rb = 0; rb < 2; ++rb) {
#pragma unroll
        for (int r = 0; r < 16; ++r) red[(wave * 64 + 32 * rb + (r & 3) + 8 * (r >> 2) + 4 * (lane >> 5)) * RED_STRIDE + (lane & 31)] = acc[rb][r];
        sst[wave * 128 + rb * 64 + lane] = ss[rb]; }
}
template <int NC>
__device__ __forceinline__ void rowdots_collect(const LAS float* red, const LAS float* sst, int lane, float (&a)[NC], float& ssum) {
#pragma unroll
    for (int n = 0; n < NC; ++n) { float s = 0.f;
#pragma unroll
        for (int w = 0; w < 8; ++w) s += red[(w * 64 + lane) * RED_STRIDE + n]; a[n] = s; }
    float s = 0.f;
#pragma unroll
    for (int w = 0; w < 8; ++w) s += sst[w * 128 + (lane >> 5) * 64 + (lane & 31)] + sst[w * 128 + (lane >> 5) * 64 + 32 + (lane & 31)];
    ssum = s;
}
__device__ __forceinline__ void slot_bases(Frame& F, const unsigned* cnt, LAS int* sb) {
    if (F.tid < 64) {
        const int c = F.tid < 16 ? (int)ldu(cnt + F.tid) : 0, p = ((c + 255) >> 8) << 8; int x = p;
#pragma unroll
        for (int off = 1; off < 16; off <<= 1) { const int n = __shfl_up(x, off); if (F.tid >= off) x += n; }
        if (F.tid < 16) { sb[F.tid] = x - p; ((LAS int*)(F.lds + RSTAB_OFF + 3072))[F.tid] = c; }
        if (F.tid == 15) sb[16] = x; }
    __syncthreads();
}

template <class Idle>
__device__ __forceinline__ void router_phase(Frame& F, const bf16* h, const float* gain, const float* wg, const float* wr, unsigned* cnt, unsigned* route, int* rowtab, const Idle& idle) {
    int tid_ = threadIdx.x; asm volatile("" : "+v"(tid_));
    const int lane = tid_ & 63, wave = __builtin_amdgcn_readfirstlane(tid_ >> 6);
    LAS float* tile = (LAS float*)(F.lds + wave * DOT_TILE_BYTES);
    LAS float* red = (LAS float*)F.lds;
    LAS float* sst = (LAS float*)(F.lds + 8 * 64 * RED_STRIDE * 4);
    u32x4v bh[4][2], bl[4][2];
    { const int col = lane & 31, hi = lane >> 5;
#pragma unroll
      for (int ch = 0; ch < 4; ++ch)
#pragma unroll
          for (int st = 0; st < 2; ++st) { float w[8];
#pragma unroll
              for (int j = 0; j < 8; ++j) { const int k = wave * 128 + ch * 32 + st * 16 + hi * 8 + j;
                  const float* src = col < 4 ? wg + k * 4 + col : wr + k * 16 + (col < 20 ? col - 4 : 0);
                  w[j] = *src * gain[k] * (col < 20 ? 1.f : 0.f); }
              { unsigned h_, l_; split2(w[0], w[1], h_, l_); bh[ch][st].x = h_; bl[ch][st].x = l_; } { unsigned h_, l_; split2(w[2], w[3], h_, l_); bh[ch][st].y = h_; bl[ch][st].y = l_; } { unsigned h_, l_; split2(w[4], w[5], h_, l_); bh[ch][st].z = h_; bl[ch][st].z = l_; } { unsigned h_, l_; split2(w[6], w[7], h_, l_); bh[ch][st].w = h_; bl[ch][st].w = l_; } } }
    for (int rb = F.vcu; rb < M / 64; rb += F.G) {
        const int r0 = rb * 64; float ss[2] = {0.f, 0.f}; f32x16 acc[2]; acc[0] = f32x16{}; acc[1] = f32x16{};
        const int row_l = lane >> 3, c4 = (lane & 7) * 4;
        unsigned long long pre[8];
#pragma unroll
        for (int i = 0; i < 8; ++i) pre[i] = *(const GAS unsigned long long*)(h + (size_t)(r0 + row_l + 8 * i) * D + wave * 128 + c4);
#pragma unroll
        for (int ch = 0; ch < 4; ++ch) { const int k0 = wave * 128 + ch * 32;
#pragma unroll
            for (int i = 0; i < 8; ++i) { const int row = row_l + 8 * i; const unsigned pl = (unsigned)pre[i], ph = (unsigned)(pre[i] >> 32); *(LAS f32x4*)(tile + row * DOT_STRIDE + c4) = (f32x4){bflo(pl), bfhi(pl), bflo(ph), bfhi(ph)}; }
            if (ch < 3) {
#pragma unroll
                for (int i = 0; i < 8; ++i) pre[i] = *(const GAS unsigned long long*)(h + (size_t)(r0 + row_l + 8 * i) * D + k0 + 32 + c4); }
            LDS_WAIT(); asm volatile("" ::: "memory");
            rowdots_chunk_mfma<true>(tile, lane, bh[ch], bl[ch], acc, ss);
            LDS_WAIT(); asm volatile("" ::: "memory");
        }
        __syncthreads();
        rowdots_publish(red, sst, wave, lane, acc, ss);
        __syncthreads();
        LAS float* fin = (LAS float*)(F.lds + 8 * 64 * RED_STRIDE * 4 + 4096 + 7 * 8448);
#pragma unroll
        for (int q3 = 0; q3 < 3; ++q3) { const int n = wave + 8 * q3; if (n < 20) { float s_ = 0.f;
#pragma unroll
                for (int w = 0; w < 8; ++w) s_ += red[(w * 64 + lane) * RED_STRIDE + n]; fin[n * 64 + lane] = s_; }
            else if (n == 20) { float s_ = 0.f;
#pragma unroll
                for (int w = 0; w < 8; ++w) s_ += sst[w * 128 + (lane >> 5) * 64 + (lane & 31)] + sst[w * 128 + (lane >> 5) * 64 + 32 + (lane & 31)]; fin[20 * 64 + lane] = s_; } }
        __syncthreads();
        if (wave == 0) {
            float a[20]; float ssum;
#pragma unroll
            for (int n = 0; n < 20; ++n) a[n] = fin[n * 64 + lane];
            ssum = fin[20 * 64 + lane];
            const float rstd = 1.f / sqrtf(ssum * (1.f / D) + RMS_EPS);
            float lg[4];
#pragma unroll
            for (int g = 0; g < 4; ++g) lg[g] = a[g] * rstd;
            int gi = 0; float best = lg[0];
#pragma unroll
            for (int g = 1; g < 4; ++g) if (lg[g] > best) { best = lg[g]; gi = g; }
            float den = 0.f;
#pragma unroll
            for (int g = 0; g < 4; ++g) den += __expf(lg[g] - best);
            const float gprob = 1.f / den;
            float le[4];
#pragma unroll
            for (int j = 0; j < 4; ++j) le[j] = rstd * (gi == 0 ? a[4 + j] : gi == 1 ? a[8 + j] : gi == 2 ? a[12 + j] : a[16 + j]);
            int i0 = 0; float t0 = le[0];
#pragma unroll
            for (int j = 1; j < 4; ++j) if (le[j] > t0) { t0 = le[j]; i0 = j; }
            int i1 = -1; float t1 = -INFINITY;
#pragma unroll
            for (int j = 0; j < 4; ++j) if (j != i0 && le[j] > t1) { t1 = le[j]; i1 = j; }
            const float ex = __expf(t1 - t0), w0 = gprob / (1.f + ex), w1 = gprob * ex / (1.f + ex);
            const int e0 = gi * 4 + i0, e1 = gi * 4 + i1;
            int mycount = 0, p0 = 0, p1 = 0; const unsigned long long lt = (1ull << lane) - 1ull;
#pragma unroll
            for (int e = 0; e < 16; ++e) { const unsigned long long mk = __ballot(e0 == e || e1 == e); const int c = __popcll(mk), before = __popcll(mk & lt);
                if (lane == e) mycount = c; if (e0 == e) p0 = before; if (e1 == e) p1 = before; }
            unsigned basev = 0;
            if (lane < 16) basev = __hip_atomic_fetch_add(cnt + lane, (unsigned)mycount, __ATOMIC_RELAXED, __HIP_MEMORY_SCOPE_AGENT);
            const unsigned b0 = __shfl(basev, e0), b1 = __shfl(basev, e1);
            unsigned* rt = route + (size_t)(r0 + lane) * 8;
            v4u q; q.x = (unsigned)e0 | ((unsigned)e1 << 8); q.y = b0 + (unsigned)p0; q.z = b1 + (unsigned)p1; q.w = __float_as_uint(w0);
            *(v4u*)rt = q; rt[4] = __float_as_uint(w1); rt[5] = __float_as_uint(rstd);
            { att::u32x2 te_; te_.x = (unsigned)(r0 + lane); te_.y = __float_as_uint(rstd); ((att::u32x2*)rowtab)[e0 * M + (int)q.y] = te_; ((att::u32x2*)rowtab)[e1 * M + (int)q.z] = te_; }
        } else { idle(rb); }
        __syncthreads();
    }
}
__device__ __forceinline__ void combine_prep_phase(Frame& F, const bf16* h, const bf16* Y, const unsigned* cnt, const unsigned* route, const float* kvg, const float* wkvf, const float* bf_, bf16* hout, float* rstd_out, float* logf) {
    int tid_ = threadIdx.x; asm volatile("" : "+v"(tid_));
    const int lane = tid_ & 63, wave = __builtin_amdgcn_readfirstlane(tid_ >> 6);
    LAS int* sb = (LAS int*)(F.lds + LDSCTL_OFF + 64);
    slot_bases(F, cnt, sb);
    LAS float* tile = (LAS float*)(F.lds + wave * DOT_TILE_BYTES);
    LAS float* red = (LAS float*)F.lds;
    LAS float* sst = (LAS float*)(F.lds + 8 * 64 * RED_STRIDE * 4);
    const int bcol = lane & 15, bhi = lane >> 5; const float bmask = (lane & 31) < 16 ? 1.f : 0.f;
    for (int rb = F.vcu; rb < M / 64; rb += F.G) {
        const int r0 = rb * 64; float ss[2] = {0.f, 0.f}; f32x16 acc[2]; acc[0] = f32x16{}; acc[1] = f32x16{};
        const int row_l = lane >> 2, c8 = (lane & 3) * 8;
        int s0[4], s1[4]; float w0[4], w1[4];
#pragma unroll
        for (int i = 0; i < 4; ++i) { const size_t m = (size_t)(r0 + row_l + 16 * i); const v4u q = *(const GAS v4u*)(route + m * 8); w0[i] = __uint_as_float(q.w); w1[i] = __uint_as_float(ldu(route + m * 8 + 4));
            s0[i] = sb[q.x & 255] + (int)q.y; s1[i] = sb[(q.x >> 8) & 255] + (int)q.z; }
#pragma unroll 1
        for (int ch = 0; ch < 4; ++ch) { const int k0 = wave * 128 + ch * 32;
            u32x4v bh[2], bl[2];
#pragma unroll
            for (int st = 0; st < 2; ++st) { float w[8];
#pragma unroll
                for (int j = 0; j < 8; ++j) { const int k = k0 + st * 16 + bhi * 8 + j; w[j] = wkvf[(size_t)k * 2064 + 2048 + bcol] * kvg[k] * bmask; }
                { unsigned h_, l_; split2(w[0], w[1], h_, l_); bh[st].x = h_; bl[st].x = l_; } { unsigned h_, l_; split2(w[2], w[3], h_, l_); bh[st].y = h_; bl[st].y = l_; } { unsigned h_, l_; split2(w[4], w[5], h_, l_); bh[st].z = h_; bl[st].z = l_; } { unsigned h_, l_; split2(w[6], w[7], h_, l_); bh[st].w = h_; bl[st].w = l_; } }
            v4u ph_[4], py0[4], py1[4];
#pragma unroll
            for (int i = 0; i < 4; ++i) { ph_[i] = *(const GAS v4u*)(h + (size_t)(r0 + row_l + 16 * i) * D + k0 + c8);
                py0[i] = *(const GAS v4u*)(Y + (size_t)s0[i] * D + k0 + c8); py1[i] = *(const GAS v4u*)(Y + (size_t)s1[i] * D + k0 + c8); }
#pragma unroll
            for (int i = 0; i < 4; ++i) { const int row = row_l + 16 * i; const size_t m = (size_t)(r0 + row); float v[8];
                const unsigned hw[4] = {ph_[i].x, ph_[i].y, ph_[i].z, ph_[i].w}, a0[4] = {py0[i].x, py0[i].y, py0[i].z, py0[i].w}, a1[4] = {py1[i].x, py1[i].y, py1[i].z, py1[i].w};
#pragma unroll
                for (int j = 0; j < 4; ++j) { v[2 * j] = bflo(hw[j]) + w0[i] * bflo(a0[j]) + w1[i] * bflo(a1[j]); v[2 * j + 1] = bfhi(hw[j]) + w0[i] * bfhi(a0[j]) + w1[i] * bfhi(a1[j]); }
                v4u o; o.x = cvtpk2(v[0], v[1]); o.y = cvtpk2(v[2], v[3]); o.z = cvtpk2(v[4], v[5]); o.w = cvtpk2(v[6], v[7]);
                *(GAS v4u*)(hout + m * D + k0 + c8) = o;
                *(LAS f32x4*)(tile + row * DOT_STRIDE + c8) = (f32x4){v[0], v[1], v[2], v[3]}; *(LAS f32x4*)(tile + row * DOT_STRIDE + c8 + 4) = (f32x4){v[4], v[5], v[6], v[7]}; }
            LDS_WAIT(); asm volatile("" ::: "memory");
            rowdots_chunk_mfma(tile, lane, bh, bl, acc, ss);
            LDS_WAIT(); asm volatile("" ::: "memory");
        }
        __syncthreads();
        rowdots_publish(red, sst, wave, lane, acc, ss);
        __syncthreads();
        if (wave == 0) {
            float a[16]; float ssum; rowdots_collect<16>(red, sst, lane, a, ssum);
            const float rstd = 1.f / sqrtf(ssum * (1.f / D) + RMS_EPS);
            rstd_out[r0 + lane] = rstd;
            float lf[16];
#pragma unroll
            for (int n = 0; n < 16; ++n) { const float xg = a[n] * rstd + bf_[n]; lf[n] = fminf(xg, 0.f) - log1pf(__expf(-fabsf(xg))); }
            GAS f32x4* lo = (GAS f32x4*)(logf + (size_t)(r0 + lane) * 16);
#pragma unroll
            for (int j = 0; j < 4; ++j) lo[j] = (f32x4){lf[4 * j], lf[4 * j + 1], lf[4 * j + 2], lf[4 * j + 3]};
        }
        __syncthreads();
    }
}
__device__ __forceinline__ void combine_prep_rows(Frame& F, const bf16* h, const bf16* Y, const unsigned* cnt, const unsigned* route, const float* kvg, const float* wkvf, const float* bf_, bf16* hout, float* rstd_out, float* logf) {
    int tid_ = threadIdx.x; asm volatile("" : "+v"(tid_));
    const int tid = tid_, lane = tid & 63, wave = __builtin_amdgcn_readfirstlane(tid >> 6);
    LAS int* sb = (LAS int*)(F.lds + LDSCTL_OFF + 64);
    slot_bases(F, cnt, sb);
    constexpr int TAB = 32768, ZOFF = 2 * TAB, TILE0 = ZOFF + 64, TSTRIDE = 68, TSZ = 9 * TSTRIDE * 4 + 256;
    LAS v4u* tabH = (LAS v4u*)F.lds; LAS v4u* tabL = (LAS v4u*)(F.lds + TAB);
#pragma unroll 1
    for (int i = 0; i < 4; ++i) { const int e = tid + 512 * i, s_ = e >> 5, hi_ = (e >> 4) & 1, col = e & 15; float w[8];
#pragma unroll
        for (int j = 0; j < 8; ++j) { const int k = 16 * s_ + 8 * hi_ + j; w[j] = wkvf[(size_t)k * 2064 + 2048 + col] * kvg[k]; }
        v4u H, L; { unsigned h_, l_; split2(w[0], w[1], h_, l_); H.x = h_; L.x = l_; } { unsigned h_, l_; split2(w[2], w[3], h_, l_); H.y = h_; L.y = l_; }
        { unsigned h_, l_; split2(w[4], w[5], h_, l_); H.z = h_; L.z = l_; } { unsigned h_, l_; split2(w[6], w[7], h_, l_); H.w = h_; L.w = l_; }
        tabH[e] = H; tabL[e] = L; }
    LAS float* tile = (LAS float*)(F.lds + TILE0 + wave * TSZ); LAS float* ssc = tile + 9 * TSTRIDE;
    if (tid < 16) ((LAS unsigned*)(F.lds + ZOFF))[tid] = 0u;
    for (int c = lane; c < TSTRIDE; c += 64) tile[8 * TSTRIDE + c] = 0.f;
    __syncthreads();
    const int srow = lane >> 3, c8 = (lane & 7) * 8;
    const int ar = lane & 31, ahi = lane >> 5, arow = ar < 8 ? ar : 8;
    const int bidx0 = ar < 16 ? ahi * 16 + ar : -1;
    for (int g = F.vcu * NWAVES + wave; g < M / 8; g += F.G * NWAVES) {
        const int R = g * 8; const size_t m = (size_t)(R + srow);
        const v4u q = *(const GAS v4u*)(route + m * 8); const float w0 = __uint_as_float(q.w), w1 = __uint_as_float(ldu(route + m * 8 + 4));
        const int s0 = sb[q.x & 255] + (int)q.y, s1 = sb[(q.x >> 8) & 255] + (int)q.z;
        const bf16* hp = h + m * D + c8; const bf16* y0p = Y + (size_t)s0 * D + c8; const bf16* y1p = Y + (size_t)s1 * D + c8; bf16* op = hout + m * D + c8;
        f32x16 acc = f32x16{}; float ss = 0.f;
        v4u lhA, l0A, l1A, lhB, l0B, l1B, lhC, l0C, l1C;
#define C1R_LOAD(S_, c_) do { lh##S_ = *(const GAS v4u*)(hp + 64 * (c_)); l0##S_ = *(const GAS v4u*)(y0p + 64 * (c_)); l1##S_ = *(const GAS v4u*)(y1p + 64 * (c_)); } while (0)
#define C1R_PROC(S_, c_) do { const v4u qh = lh##S_, a0 = l0##S_, a1 = l1##S_; float v[8]; \
            const unsigned hw[4] = {qh.x, qh.y, qh.z, qh.w}, y0w[4] = {a0.x, a0.y, a0.z, a0.w}, y1w[4] = {a1.x, a1.y, a1.z, a1.w}; \
            _Pragma("unroll") for (int j = 0; j < 4; ++j) { v[2 * j] = bflo(hw[j]) + w0 * bflo(y0w[j]) + w1 * bflo(y1w[j]); v[2 * j + 1] = bfhi(hw[j]) + w0 * bfhi(y0w[j]) + w1 * bfhi(y1w[j]); } \
            v4u o; o.x = cvtpk2(v[0], v[1]); o.y = cvtpk2(v[2], v[3]); o.z = cvtpk2(v[4], v[5]); o.w = cvtpk2(v[6], v[7]); \
            *(GAS v4u*)(op + 64 * (c_)) = o; \
            *(LAS f32x4*)(tile + srow * TSTRIDE + c8) = (f32x4){v[0], v[1], v[2], v[3]}; *(LAS f32x4*)(tile + srow * TSTRIDE + c8 + 4) = (f32x4){v[4], v[5], v[6], v[7]}; \
            LDS_WAIT(); asm volatile("" ::: "memory"); \
            _Pragma("unroll") for (int st = 0; st < 4; ++st) { const LAS f32x4* ap = (const LAS f32x4*)(tile + arow * TSTRIDE + 16 * st + 8 * ahi); const f32x4 x0 = ap[0], x1 = ap[1]; \
                ss += (x0.x * x0.x + x0.y * x0.y) + (x0.z * x0.z + x0.w * x0.w) + (x1.x * x1.x + x1.y * x1.y) + (x1.z * x1.z + x1.w * x1.w); \
                u32x4v ah, al; { unsigned h_, l_; split2(x0.x, x0.y, h_, l_); ah.x = h_; al.x = l_; } { unsigned h_, l_; split2(x0.z, x0.w, h_, l_); ah.y = h_; al.y = l_; } \
                { unsigned h_, l_; split2(x1.x, x1.y, h_, l_); ah.z = h_; al.z = l_; } { unsigned h_, l_; split2(x1.z, x1.w, h_, l_); ah.w = h_; al.w = l_; } \
                const int be = bidx0 < 0 ? (ZOFF / 16) : bidx0 + (4 * (c_) + st) * 32; \
                const v4u bhv = tabH[be], blv = bidx0 < 0 ? tabH[be] : tabL[be]; \
                const bfx8 Ah = __builtin_bit_cast(bfx8, ah), Al = __builtin_bit_cast(bfx8, al), Bh = __builtin_bit_cast(bfx8, bhv), Bl = __builtin_bit_cast(bfx8, blv); \
                acc = __builtin_amdgcn_mfma_f32_32x32x16_bf16(Ah, Bh, acc, 0, 0, 0); \
                acc = __builtin_amdgcn_mfma_f32_32x32x16_bf16(Ah, Bl, acc, 0, 0, 0); \
                acc = __builtin_amdgcn_mfma_f32_32x32x16_bf16(Al, Bh, acc, 0, 0, 0); } \
            LDS_WAIT(); asm volatile("" ::: "memory"); } while (0)
        C1R_LOAD(A, 0); C1R_LOAD(B, 1); C1R_LOAD(C, 2);
#pragma unroll 1
        for (int c = 0; c < 15; c += 3) {
            C1R_PROC(A, c); C1R_LOAD(A, c + 3);
            C1R_PROC(B, c + 1); if (c + 4 < 16) C1R_LOAD(B, c + 4);
            C1R_PROC(C, c + 2); if (c + 5 < 16) C1R_LOAD(C, c + 5);
        }
        C1R_PROC(A, 15);
#undef C1R_LOAD
#undef C1R_PROC
        ssc[lane] = ss; LDS_WAIT(); asm volatile("" ::: "memory");
        if (lane < 8) rstd_out[R + lane] = 1.f / sqrtf((ssc[lane] + ssc[lane + 32]) * (1.f / D) + RMS_EPS);
        if (ar < 16) { const float bfc = bf_[ar];
#pragma unroll
            for (int r = 0; r < 4; ++r) { const int row = 4 * ahi + r; const float rs = 1.f / sqrtf((ssc[row] + ssc[row + 32]) * (1.f / D) + RMS_EPS);
                const float xg = acc[r] * rs + bfc; logf[(size_t)(R + row) * 16 + ar] = fminf(xg, 0.f) - log1pf(__expf(-fabsf(xg))); } }
        LDS_WAIT(); asm volatile("" ::: "memory");
    }
}
__device__ __forceinline__ void final_phase(Frame& F, const bf16* h, float* out, const bf16* Y, const unsigned* cnt, const unsigned* route, const float* gain) {
    int tid_ = threadIdx.x; asm volatile("" : "+v"(tid_));
    const int lane = tid_ & 63, wave = __builtin_amdgcn_readfirstlane(tid_ >> 6);
    LAS int* sb = (LAS int*)(F.lds + LDSCTL_OFF + 64);
    slot_bases(F, cnt, sb);
    const int gw = F.vcu * NWAVES + wave, NGW = F.G * NWAVES;
    f32x4 gv[4];
#pragma unroll
    for (int j = 0; j < 4; ++j) gv[j] = *((const GAS f32x4*)gain + lane + 64 * j);
    unsigned long long nv[4]; unsigned long long ny0[4], ny1[4]; float nw0 = 0.f, nw1 = 0.f; unsigned rv2 = 0;
#define F_ROUTE(m_) (((m_) < M) ? route[(size_t)(m_) * 8 + (lane & 7)] : 0u)
#define F_LOAD(m_, rv_) do { const unsigned q0_ = __builtin_amdgcn_readlane(rv_, 0); \
        const int s0_ = sb[q0_ & 255] + (int)__builtin_amdgcn_readlane(rv_, 1), s1_ = sb[(q0_ >> 8) & 255] + (int)__builtin_amdgcn_readlane(rv_, 2); \
        nw0 = __uint_as_float(__builtin_amdgcn_readlane(rv_, 3)); nw1 = __uint_as_float(__builtin_amdgcn_readlane(rv_, 4)); \
        const GAS unsigned long long* xr_ = (const GAS unsigned long long*)(h + (size_t)(m_) * D) + lane; \
        const GAS unsigned long long* y0p_ = (const GAS unsigned long long*)(Y + (size_t)s0_ * D) + lane; const GAS unsigned long long* y1p_ = (const GAS unsigned long long*)(Y + (size_t)s1_ * D) + lane; \
        _Pragma("unroll") for (int j = 0; j < 4; ++j) { nv[j] = xr_[64 * j]; ny0[j] = y0p_[64 * j]; ny1[j] = y1p_[64 * j]; } } while (0)
    int m = gw;
    if (m < M) { const unsigned rv0 = F_ROUTE(m); rv2 = F_ROUTE(m + NGW); F_LOAD(m, rv0); }
    for (; m < M; m += NGW) {
        f32x4 v[4]; unsigned long long y0[4], y1[4]; const float w0 = nw0, w1 = nw1;
#pragma unroll
        for (int j = 0; j < 4; ++j) { const unsigned pl = (unsigned)nv[j], ph = (unsigned)(nv[j] >> 32); v[j] = (f32x4){bflo(pl), bfhi(pl), bflo(ph), bfhi(ph)}; y0[j] = ny0[j]; y1[j] = ny1[j]; }
        const unsigned rv1 = rv2;
        if (m + NGW < M) { rv2 = F_ROUTE(m + 2 * NGW); F_LOAD(m + NGW, rv1); }
        float s = 0.f;
#pragma unroll
        for (int j = 0; j < 4; ++j) { const unsigned y0l = (unsigned)y0[j], y0h = (unsigned)(y0[j] >> 32), y1l = (unsigned)y1[j], y1h = (unsigned)(y1[j] >> 32);
            v[j].x += w0 * bflo(y0l) + w1 * bflo(y1l); v[j].y += w0 * bfhi(y0l) + w1 * bfhi(y1l); v[j].z += w0 * bflo(y0h) + w1 * bflo(y1h); v[j].w += w0 * bfhi(y0h) + w1 * bfhi(y1h);
            s += (v[j].x * v[j].x + v[j].y * v[j].y) + (v[j].z * v[j].z + v[j].w * v[j].w); }
        const float rstd = 1.f / sqrtf(wave_sum(s) * (1.f / D) + RMS_EPS);
        GAS f32x4* xr = (GAS f32x4*)(out + (size_t)m * D) + lane;
#pragma unroll
        for (int j = 0; j < 4; ++j) __builtin_nontemporal_store(v[j] * gv[j] * rstd, xr + 64 * j);
    }
#undef F_ROUTE
#undef F_LOAD
}

template <bool GATEUP>
__device__ __forceinline__ void moe_mini(const Frame& F, const LAS int* pt, const LAS int* ecnt, int u_lo, int u_hi, const bf16* A, const bf16* Bt, bf16* Out, const int* rowtab, const unsigned* route) {
    constexpr int K = GATEUP ? D : FE, NC = K / 64, NBUF = 5, BUFB = 24576;
    int lane_ = threadIdx.x & 63; asm volatile("" : "+v"(lane_)); const int lane = lane_, r32 = lane & 31, hi = lane >> 5, dkey = lane >> 3, dj = lane & 7;
    const int w = F.wave, tb = w & 3, wg = w >> 2;
    const LAS char* lp = (const LAS char*)F.lds;
    const unsigned l0 = (unsigned)__builtin_amdgcn_readfirstlane((unsigned)(size_t)lp);
    int koff[4];
#pragma unroll
    for (int d0 = 0; d0 < 4; ++d0) koff[d0] = r32 * 128 + (((2 * d0 + hi) ^ ((r32 >> 1) & 7)) * 16);
    const int woff = wg * 4096, toff = 8192 + tb * 4096;
    for (int ct = (int)blockIdx.x; ct < (u_hi - u_lo) * 8; ct += F.G) {
        const int wgid = u_lo + (ct >> 3), th = ct & 1, cg = (ct >> 1) & 3, rt = wgid >> 2, j = wgid & 3;
        int e = 0;
#pragma unroll
        for (int k = 1; k < 16; ++k) e += (pt[k] <= rt) ? 1 : 0;
        const int rowT = rt * 256 + th * 128, pos0 = (rt - pt[e]) * 256 + th * 128, last = GATEUP ? ecnt[e] - 1 : 0;
        const bf16* src[3]; unsigned dst[3]; float rs = 1.f;
#pragma unroll
        for (int i = 0; i < 3; ++i) { const int q = 3 * w + i;
            if (q < 8) { const int R = 8 * q + dkey, m = R & 31;
                const int wrow = e * 1024 + j * 256 + (GATEUP ? cg * 32 + (R >> 5) * 16 + (m & 15) + (m >> 4) * 128 : cg * 64 + R);
                src[i] = Bt + (size_t)wrow * K + (dj ^ ((R >> 1) & 7)) * 8; dst[i] = (unsigned)q * 1024u; }
            else { const int R = 8 * (q - 8) + dkey; size_t row;
                if constexpr (GATEUP) { const int pos = pos0 + R; row = (size_t)((const att::u32x2*)rowtab)[(size_t)e * M + (pos < last ? pos : last)].x; } else row = (size_t)(rowT + R);
                src[i] = A + row * K + (dj ^ ((R >> 1) & 7)) * 8; dst[i] = 8192u + (unsigned)(q - 8) * 1024u; } }
        if constexpr (GATEUP) { const int posr = pos0 + tb * 32 + r32; rs = __uint_as_float(((const att::u32x2*)rowtab)[(size_t)e * M + (posr < last ? posr : last)].y); }
#define MINI_DMA(c_, buf_) do { _Pragma("unroll") for (int i_ = 0; i_ < 3; ++i_) att::glds16(src[i_] + (c_) * 64, l0 + (unsigned)(buf_) * (unsigned)BUFB + dst[i_]); } while (0)
#pragma unroll
        for (int c = 0; c < NBUF - 1; ++c) MINI_DMA(c, c);
        att::f32x16 acc = att::f32x16{};
        int bufc = 0, bufn = NBUF - 1;
        for (int c = 0; c < NC; ++c) {
            const int rem = NC - 1 - c;
            if (rem >= 3) asm volatile("s_waitcnt vmcnt(9)" ::: "memory"); else if (rem == 2) asm volatile("s_waitcnt vmcnt(6)" ::: "memory");
            else if (rem == 1) asm volatile("s_waitcnt vmcnt(3)" ::: "memory"); else asm volatile("s_waitcnt vmcnt(0)" ::: "memory");
            asm volatile("s_barrier" ::: "memory");
            if (c + NBUF - 1 < NC) MINI_DMA(c + NBUF - 1, bufn);
            const LAS char* b = lp + bufc * BUFB;
            att::bf16x8 wf[4], tf[4];
#pragma unroll
            for (int d0 = 0; d0 < 4; ++d0) { wf[d0] = *(const LAS att::bf16x8*)(b + woff + koff[d0]); tf[d0] = *(const LAS att::bf16x8*)(b + toff + koff[d0]); }
            asm volatile("s_waitcnt lgkmcnt(0)" ::: "memory");
#pragma unroll
            for (int d0 = 0; d0 < 4; ++d0) acc = __builtin_amdgcn_mfma_f32_32x32x16_bf16(wf[d0], tf[d0], acc, 0, 0, 0);
            bufc = bufc + 1 == NBUF ? 0 : bufc + 1; bufn = bufn + 1 == NBUF ? 0 : bufn + 1;
        }
#undef MINI_DMA
        if constexpr (GATEUP) {
            bf16* op = Out + (size_t)(rowT + tb * 32 + r32) * FE + j * 128 + cg * 32 + wg * 16 + 4 * hi;
#pragma unroll
            for (int q = 0; q < 2; ++q) { float hv[4];
#pragma unroll
                for (int jj = 0; jj < 4; ++jj) { const float g = acc[4 * q + jj] * rs, up = acc[8 + 4 * q + jj] * rs;
                    hv[jj] = g * __builtin_amdgcn_rcpf(1.f + __builtin_amdgcn_exp2f(-1.4426950408889634f * g)) * up; }
                att::u32x2 wv; wv.x = att::cvtpk(hv[0], hv[1]); wv.y = att::cvtpk(hv[2], hv[3]); *(att::u32x2*)(op + 8 * q) = wv; }
        } else {
            bf16* op = Out + (size_t)(rowT + tb * 32 + r32) * D + j * 256 + cg * 64 + wg * 32 + 4 * hi;
#pragma unroll
            for (int q = 0; q < 4; ++q) { att::u32x2 wv; wv.x = att::cvtpk(acc[4 * q], acc[4 * q + 1]); wv.y = att::cvtpk(acc[4 * q + 2], acc[4 * q + 3]); *(att::u32x2*)(op + 8 * q) = wv; }
        }
        asm volatile("s_waitcnt vmcnt(0)" ::: "memory");
        __syncthreads();
    }
}

struct Args { const float* in[16]; float* out; unsigned char* ws; int ph_lo, ph_hi; };
__global__ void __launch_bounds__(NWAVES * 64, 2) fwd_kernel(Args args) {
    extern __shared__ __attribute__((aligned(16))) unsigned char lds[];
    Frame F;
    F.lds = (LAS unsigned char*)lds;
    F.MISC = (volatile LAS unsigned*)(F.lds + MISC_OFF);
    F.tid = threadIdx.x; F.lane = F.tid & 63; F.wave = __builtin_amdgcn_readfirstlane(F.tid >> 6);
    F.G = gridDim.x; { const int bx = blockIdx.x; F.vcu = (F.G % 8 == 0) ? (bx % 8) * (F.G / 8) + bx / 8 : bx; }
    unsigned char* ws = args.ws;
    F.ctl = (gu32*)(ws + WS_CTL);
    In I; I.x = args.in[0]; I.attn_norm = args.in[1]; I.w_qkv_a = args.in[2]; I.w_o_a = args.in[3]; I.kv_norm = args.in[4]; I.w_kvf = args.in[5]; I.b_f = args.in[6]; I.w_q_b = args.in[7];
    I.w_o_b = args.in[8]; I.moe_norm = args.in[9]; I.w_group = args.in[10]; I.w_router = args.in[11]; I.w_gate = args.in[12]; I.w_up = args.in[13]; I.w_down = args.in[14]; I.final_norm = args.in[15];
    bf16* HB0 = (bf16*)args.out;
    bf16* HB1 = (bf16*)(ws + WS_WGU);
    bf16* Wqkv = (bf16*)(ws + WS_WQKV); bf16* Woa = (bf16*)(ws + WS_WOA); bf16* Wkvq = (bf16*)(ws + WS_WKVQ); bf16* Wob = (bf16*)(ws + WS_WOB);
    bf16* Wgu = (bf16*)(ws + WS_WGU); bf16* Wd = (bf16*)(ws + WS_WD);
    bf16* Qb = (bf16*)(ws + WS_Q); bf16* Kb = (bf16*)(ws + WS_K); bf16* Vb = (bf16*)(ws + WS_V); bf16* XB = (bf16*)(ws + WS_XB);
    bf16* Hs = (bf16*)(ws + WS_HS); bf16* Yb = (bf16*)(ws + WS_Y); int* rowtab = (int*)(ws + WS_ROWTAB);
    float* rstd = (float*)(ws + WS_RSTD); unsigned* route = (unsigned*)(ws + WS_ROUTE); float* logf = (float*)(ws + WS_LOGF);
    unsigned* cntw = (unsigned*)(ws + WS_CTL) + CW_CNT;
    for (int u = F.tid; u < (LDS_BYTES - LDSCTL_OFF) / 4; u += NWAVES * 64) ((LAS unsigned*)(F.lds + LDSCTL_OFF))[u] = 0u;
    __syncthreads();
    const int lo = args.ph_lo, hi = args.ph_hi;
    const bool multi = (hi - lo) > 1;
    XcdBarrier bar; bar.bar = (unsigned*)(F.ctl + CW_BAR); bar.x = 0; bar.st = nullptr;
    if (multi) bar = xcd_barrier_post((unsigned*)(F.ctl + CW_BAR), F.MISC + 8);
#ifndef PHMASK
#define PHMASK 0x1ffffu
#endif
#define IN(k) (((PHMASK >> (k)) & 1u) && lo <= (k) && (k) < hi)
#define SHADOW_ITEM(decode_, it_) do { int lane_ = threadIdx.x & 63; asm volatile("" : "+v"(lane_)); f32x4 v_[8]; float g_[8]; const TItem t_ = decode_(I, ws, it_); \
        titem32_load(t_, lane_, v_, g_); titem32_store(t_, lane_, v_, g_, (LAS float*)(F.lds + F.wave * 16384)); } while (0)
#define SEAM(k) do { if (IN(k) && IN((k) + 1)) { const int sl_ = (int)blockIdx.x * 7 + (F.wave - 1); \
        if ((k) < 5 && F.G == 256) { const int it_ = (k) * SHADOW_PER_BAR + sl_; xcd_barrier(bar, [&]() { SHADOW_ITEM(shadow_decode, it_); }); } \
        else if (((k) == 8 || (k) == 9) && F.G == 256) { const int it_ = TAIL_G4 + ((k) - 8) * SHADOW_PER_BAR + sl_; xcd_barrier(bar, [&]() { if (it_ < TAIL_ITEMS) SHADOW_ITEM(tail_decode, it_); }); } \
        else xcd_barrier(bar); } } while (0)
    LAS unsigned char* ring = F.lds;
    LAS int* sbt = (LAS int*)(F.lds + LDSCTL_OFF + 64);

#ifndef REPEAT_PH
#define REPEAT_PH -1
#endif
#define PH(k, ...) do { if (IN(k)) { __VA_ARGS__ if (REPEAT_PH == (k)) { xcd_barrier(bar); __VA_ARGS__ } } SEAM(k); } while (0)
    PH(0, { p0_prologue(F, I, ws); });
    PH(1, {
        pg8::Gemm g{XB, Wqkv, M, 3072, D}; pg8::StaticOrder S; S.init(M, 3072, F.G, (int)blockIdx.x);
        pg8::EpiSplit3 E{Qb, (size_t)(WS_K - WS_Q) / 2, 0, rstd, 0, att::C2};
        pg8::gemm_phase<pg8::EpiSplit3, pg8::StaticOrder, true, true>(ring, g, S, E); });
    PH(2, { const int gw_ = F.vcu * NWAVES + F.wave, ngw_ = F.G * NWAVES;
        att::sb_phase((ALAS char*)ring, F.vcu, F.G, Qb, Kb, Vb, Qb  , [&](int round, ALAS char* wl) { deferred_items(I, ws, gw_, ngw_, round, (LAS float*)wl); }); });
    PH(3, {
        pg8::Gemm g{Qb, Woa, M, D, D}; pg8::StaticOrder S; S.init(M, D, F.G, (int)blockIdx.x);
        pg8::EpiResidBf<true> E{XB, HB0, D};
        pg8::gemm_phase<pg8::EpiResidBf<true>, pg8::StaticOrder, true, true>(ring, g, S, E); });
    constexpr int TAIL_SPLIT = TAIL_G3;
#define MOE_TAIL(nwg_, lo_, hi_) do { const int r_ = (nwg_) % F.G; const bool all_ = (r_ == 0) || (F.G - r_ < F.G / 2); const int c_ = (int)blockIdx.x; \
        if (all_ || c_ >= r_) { const int ic_ = all_ ? c_ : c_ - r_, nid_ = all_ ? F.G : F.G - r_; \
            tail_items(I, ws, ic_ * NWAVES + F.wave, nid_ * NWAVES, lo_, hi_, (LAS float*)(F.lds + F.wave * 16384)); } } while (0)
    constexpr int MINI_MAX = 96;
#define MOE_LAYER(l, PBASE) do { \
        unsigned* cnt = cntw + 64 * (l); \
        PH(PBASE, { router_phase(F, (l) == 0 ? HB0 : HB1, I.moe_norm + (l) * D, I.w_group + (size_t)(l) * D * 4, I.w_router + (size_t)(l) * D * 16, cnt, route, rowtab, [&](int rb_) { const int it_ = rb_ * 7 + (F.wave - 1); if ((l) == 0 && it_ < ROUTER_IDLE_ITEMS) { int lane_ = threadIdx.x & 63; asm volatile("" : "+v"(lane_)); f32x4 v_[8]; float g_[8]; \
                const TItem t_ = expert_item(I, ws, 0, SHADOW_GU + it_); titem32_load(t_, lane_, v_, g_); titem32_store(t_, lane_, v_, g_, (LAS float*)(F.lds + 8 * 64 * RED_STRIDE * 4 + 4096 + (F.wave - 1) * 8448)); } }); }); \
        PH((PBASE) + 2, { \
            slot_bases(F, cnt, sbt); \
            if (F.tid < 17) sbt[32 + F.tid] = sbt[F.tid] >> 8; \
            __syncthreads(); \
            const int nu_ = (sbt[16] >> 8) * 4, lf_ = ((l) == 1 && nu_ % F.G <= MINI_MAX) ? nu_ % F.G : 0;        \
            pg8::MoeOrder S; S.pt = (const PG8_LAS int*)(sbt + 32); S.nwg = nu_ - lf_; S.G = F.G; S.c = (int)blockIdx.x; S.rowidx = (const PG8_LAS int*)(F.lds + ROWIDX_OFF); \
            { int idx_[2], tok_[2]; bool ok_[2], in_[2]; float rs_[2];        \
              _Pragma("unroll") for (int q_ = 0; q_ < 2; ++q_) { idx_[q_] = F.tid + 512 * q_; pg8::Unit u_; ok_[q_] = idx_[q_] < 768 && S.next(idx_[q_] >> 8, u_); \
                  const int e_ = ok_[q_] ? (u_.pb >> 2) : 0, pos_ = ok_[q_] ? (u_.pm - sbt[32 + e_]) * 256 + (idx_[q_] & 255) : 0; in_[q_] = ok_[q_] && pos_ < ((LAS int*)(F.lds + RSTAB_OFF + 3072))[e_]; \
                  const att::u32x2 te_ = ((const att::u32x2*)rowtab)[in_[q_] ? e_ * M + pos_ : 0]; tok_[q_] = (int)te_.x; rs_[q_] = __uint_as_float(te_.y); } \
              _Pragma("unroll") for (int q_ = 0; q_ < 2; ++q_) { tok_[q_] = in_[q_] ? tok_[q_] : 0; rs_[q_] = in_[q_] ? rs_[q_] : 0.f; }        \
              _Pragma("unroll") for (int q_ = 0; q_ < 2; ++q_) if (ok_[q_]) { ((LAS int*)(F.lds + ROWIDX_OFF))[idx_[q_]] = tok_[q_]; ((LAS float*)(F.lds + RSTAB_OFF))[idx_[q_]] = rs_[q_]; } } \
            __syncthreads(); \
            pg8::Gemm g{(l) == 0 ? HB0 : HB1, Wgu + (size_t)(l) * 16 * 1024 * 1024, M, 1024, D}; \
            pg8::EpiGateUp E{Hs, (const PG8_LAS float*)(F.lds + RSTAB_OFF)}; \
            pg8::gemm_phase<pg8::EpiGateUp, pg8::MoeOrder, true, true, true>(ring, g, S, E); \
            if ((l) == 1 && lf_ > 0) moe_mini<true>(F, sbt + 32, (const LAS int*)(F.lds + RSTAB_OFF + 3072), nu_ - lf_, nu_, HB1, Wgu + (size_t)(l) * 16 * 1024 * 1024, Hs, rowtab, route); \
            if ((l) == 0) MOE_TAIL(S.nwg, 0, TAIL_SPLIT); }); \
        PH((PBASE) + 3, { \
            if (!IN((PBASE) + 2)) { slot_bases(F, cnt, sbt); if (F.tid < 17) sbt[32 + F.tid] = sbt[F.tid] >> 8; __syncthreads(); }     \
            const int nu_ = (sbt[16] >> 8) * 4, lf_ = ((l) == 1 && nu_ % F.G <= MINI_MAX) ? nu_ % F.G : 0; \
            pg8::MoeOrder S; S.pt = (const PG8_LAS int*)(sbt + 32); S.nwg = nu_ - lf_; S.G = F.G; S.c = (int)blockIdx.x; S.rowidx = nullptr; \
            pg8::Gemm g{Hs, Wd + (size_t)(l) * 16 * 1024 * 512, SLOTS, 1024, FE}; \
            pg8::EpiBf16Plain E{Yb, D}; \
            pg8::gemm_phase<pg8::EpiBf16Plain, pg8::MoeOrder, true, true>(ring, g, S, E); \
            if ((l) == 1 && lf_ > 0) moe_mini<false>(F, sbt + 32, nullptr, nu_ - lf_, nu_, Hs, Wd + (size_t)(l) * 16 * 1024 * 512, Yb, nullptr, nullptr); \
            if ((l) == 0) MOE_TAIL(S.nwg, TAIL_SPLIT, TAIL_G4); }); \
    } while (0)
    MOE_LAYER(0, 4);
    PH(8, { combine_prep_rows(F, HB0, Yb, cntw, route, I.kv_norm, I.w_kvf, I.b_f, HB1, rstd, logf); });
    PH(9, {
        pg8::Gemm g{HB1, Wkvq, M, 3072, D}; pg8::StaticOrder S; S.init(M, 3072, F.G, (int)blockIdx.x);
        pg8::EpiSplit3 E{Qb, (size_t)(WS_K - WS_Q) / 2, 1, rstd, 2, att::C2};
        pg8::gemm_phase<pg8::EpiSplit3, pg8::StaticOrder, true, true>(ring, g, S, E); });
    PH(10, { fatt::attn_phase<8>((char*)lds, F.vcu, F.G, (const fatt::bf16*)Qb, (const fatt::bf16*)Kb, (const fatt::bf16*)Vb, (fatt::bf16*)Qb, logf); });
    PH(11, {
        pg8::Gemm g{Qb, Wob, M, D, D}; pg8::StaticOrder S; S.init(M, D, F.G, (int)blockIdx.x);
        pg8::EpiResidBf<true> E{HB1, HB1, D};
        pg8::gemm_phase<pg8::EpiResidBf<true>, pg8::StaticOrder, true, true>(ring, g, S, E); });
    MOE_LAYER(1, 12);
    PH(16, { final_phase(F, HB1, args.out, Yb, cntw + 64, route, I.final_norm); });
#undef IN
#undef SEAM
}

#ifndef N_LAUNCH_MODE
#define N_LAUNCH_MODE 1
#endif
extern "C" void kernel_launch(void* const* d_in, const int* in_sizes, int n_in, void* d_out, int out_size, void* d_ws, size_t ws_size, hipStream_t stream) {
    static int grid = 0;
    if (grid == 0) {
        if (n_in != 16 || out_size != M * D || ws_size < WS_END) { fprintf(stderr, "kernel_launch: unexpected shapes (n_in %d, out %d, ws %zu)\n", n_in, out_size, ws_size); grid = -1; return; }
        int dev = 0, cus = 0;
        if (hipGetDevice(&dev) != hipSuccess || hipDeviceGetAttribute(&cus, hipDeviceAttributeMultiprocessorCount, dev) != hipSuccess) { grid = -1; return; }
        if (hipFuncSetAttribute((const void*)fwd_kernel, hipFuncAttributeMaxDynamicSharedMemorySize, LDS_BYTES) != hipSuccess) { fprintf(stderr, "kernel_launch: hipFuncSetAttribute failed\n"); grid = -1; return; }
        int per_cu = 0;
        if (hipOccupancyMaxActiveBlocksPerMultiprocessor(&per_cu, (const void*)fwd_kernel, NWAVES * 64, LDS_BYTES) != hipSuccess || per_cu < 1) fprintf(stderr, "kernel_launch: occupancy query says %d\n", per_cu);
        (void)hipGetLastError();
        grid = cus;
    }
    if (grid < 0) return;
    (void)hipMemsetAsync((char*)d_ws + WS_CTL, 0, CTL_ZERO_BYTES, stream);
    Args a{};
    for (int i = 0; i < 16; ++i) a.in[i] = (const float*)d_in[i];
    a.out = (float*)d_out; a.ws = (unsigned char*)d_ws;
#if N_LAUNCH_MODE == 1
    a.ph_lo = 0; a.ph_hi = NPH;
    void* kargs[] = {&a};
    hipError_t e = hipLaunchCooperativeKernel((const void*)fwd_kernel, dim3(grid), dim3(NWAVES * 64), kargs, LDS_BYTES, stream);
    if (e != hipSuccess) fprintf(stderr, "kernel_launch: cooperative launch failed: %s (grid %d)\n", hipGetErrorString(e), grid);
#else
    for (int p = 0; p < NPH; ++p) { a.ph_lo = p; a.ph_hi = p + 1; hipLaunchKernelGGL(fwd_kernel, dim3(grid), dim3(NWAVES * 64), LDS_BYTES, stream, a); }
#endif
}
```

```cpp
#include <hip/hip_runtime.h>
#include <cstdio>
#include <cstdint>
#include <hip/hip_bf16.h>
#include <cmath>
namespace pg8 {
#define PG8_LAS __attribute__((address_space(3)))
typedef unsigned short bf16_t;
typedef short bf16x8 __attribute__((ext_vector_type(8)));
typedef float f32x4 __attribute__((ext_vector_type(4)));
typedef unsigned u32x4 __attribute__((ext_vector_type(4)));
constexpr int BM = 256, BK = 64, HALF = 128, HTB = HALF * BK * 2  , STAGE_BYTES = 8 * HTB, NXCD = 8, WGM = 8;

__host__ __device__ __forceinline__ int lds_byte(int r, int c) { const int st = (r >> 4) * 2 + (c >> 5), rr = r & 15, cc = c & 31, ob = rr * 64 + cc * 2; return st * 1024 + (ob ^ (((ob >> 9) & 1) << 5)); }
__host__ __device__ __forceinline__ void stage_rc(int b, int& R, int& C) { const int st = b / 1024, sb = b % 1024, swz = sb ^ (((sb >> 9) & 1) << 5); R = (st >> 1) * 16 + swz / 64; C = (st & 1) * 32 + (swz % 64) / 2; }
__host__ __device__ __forceinline__ int perm32(int rho) { const int n = rho >> 4, i = rho & 15; return 8 * (i >> 2) + 4 * n + (i & 3); }

struct Unit { int pm, pn, pb, ui; };
struct Gemm { const bf16_t* A; const bf16_t* Bt; int M, N, K; };
struct StaticOrder {
    int nM, nN, nwg, G, c;
    __host__ __device__ void init(int M, int N, int G_, int c_) { nM = M / BM; nN = N / BM; nwg = nM * nN; G = G_; c = c_; }
    __host__ __device__ __forceinline__ bool next(int i, Unit& u) const {
        const long L = (long)i * G + c; if (L >= nwg) return false;
        int wgid = (int)L; { const int q = nwg / NXCD, r = nwg % NXCD, xcd = wgid % NXCD, off = wgid / NXCD; wgid = (xcd < r ? xcd * (q + 1) : r * (q + 1) + (xcd - r) * q) + off; }
        const int nig = WGM * nN, gid = wgid / nig, fm = gid * WGM, gsz = (nM - fm) < WGM ? (nM - fm) : WGM;
        u.pm = fm + ((wgid % nig) % gsz); u.pn = (wgid % nig) / gsz; u.pb = u.pn; u.ui = i; return true;
    }
    __device__ __forceinline__ void a_ready(const Unit&) const {}
    __device__ __forceinline__ void done(const Unit&) const {}
};
struct MoeOrder {
    const PG8_LAS int* pt; int nwg, G, c; const PG8_LAS int* rowidx;
    __device__ __forceinline__ bool next(int i, Unit& u) const {
        const long L = (long)i * G + c; if (L >= nwg) return false;
        int wgid = (int)L; { const int q = nwg / NXCD, r = nwg % NXCD, xcd = wgid % NXCD, off = wgid / NXCD; wgid = (xcd < r ? xcd * (q + 1) : r * (q + 1) + (xcd - r) * q) + off; }
        const int rt = wgid >> 2, j = wgid & 3; int e = 0;
#pragma unroll
        for (int k = 1; k < 16; ++k) e += (pt[k] <= rt) ? 1 : 0;
        u.pm = rt; u.pn = j; u.pb = e * 4 + j; u.ui = i; return true;
    }
    __device__ __forceinline__ void a_ready(const Unit&) const {}
    __device__ __forceinline__ void done(const Unit&) const {}
};

__device__ __forceinline__ unsigned cvt_pk_bf16(float lo, float hi) { unsigned r; asm volatile("v_cvt_pk_bf16_f32 %0, %1, %2" : "=v"(r) : "v"(lo), "v"(hi)); return r; }
__device__ __forceinline__ unsigned pk4_fp8(float a, float b, float c, float d, float sc) {
    a = __builtin_fminf(__builtin_fmaxf(a * sc, -448.f), 448.f); b = __builtin_fminf(__builtin_fmaxf(b * sc, -448.f), 448.f);
    c = __builtin_fminf(__builtin_fmaxf(c * sc, -448.f), 448.f); d = __builtin_fminf(__builtin_fmaxf(d * sc, -448.f), 448.f);
    unsigned w = 0; w = __builtin_amdgcn_cvt_pk_fp8_f32(a, b, w, false); w = __builtin_amdgcn_cvt_pk_fp8_f32(c, d, w, true); return w; }
constexpr float F8_SA = 16.f, F8_SH = 16.f, F8_SW = 256.f, F8_SY = 32.f;
typedef int v8i_t __attribute__((ext_vector_type(8)));
typedef int v4i_t __attribute__((ext_vector_type(4)));
__device__ __forceinline__ v8i_t cat8(const bf16x8& a, const bf16x8& b) { return __builtin_shufflevector(__builtin_bit_cast(v4i_t, a), __builtin_bit_cast(v4i_t, b), 0, 1, 2, 3, 4, 5, 6, 7); }
struct EpiSplit3 {
    static constexpr bool PERM = true, AFTER_DRAIN = false, INIT_ACC = false;
    bf16_t* O0; size_t ostride; int rot; const float* rstd; int qsel; float qscale; float ds;
    __device__ __forceinline__ void operator()(const f32x4 (&acc)[2][2][4][2], const Unit& u, int wr, int wc, int fr, int fq) const {
        const int row0 = u.pm * BM + wr * 64 + fr; int colt = u.pn * BM; const int t = colt >> 10; colt &= 1023;
        int tb = t + rot; tb = tb >= 3 ? tb - 3 : tb; bf16_t* base = O0 + (size_t)tb * ostride; const float sc = ((t == qsel) ? qscale : 1.f) * ds;
        const int col0 = colt + wc * 32 + 8 * fq;
#pragma unroll
        for (int ai = 0; ai < 2; ++ai)
#pragma unroll
            for (int m = 0; m < 4; ++m) { const int row = row0 + ai * HALF + m * 16; const float rs = rstd[row] * sc; bf16_t* rowp = base + (size_t)row * 1024 + col0;
#pragma unroll
                for (int bj = 0; bj < 2; ++bj) { const f32x4 v0 = acc[ai][bj][m][0] * rs, v1 = acc[ai][bj][m][1] * rs;
                    u32x4 w; w.x = cvt_pk_bf16(v0[0], v0[1]); w.y = cvt_pk_bf16(v0[2], v0[3]); w.z = cvt_pk_bf16(v1[0], v1[1]); w.w = cvt_pk_bf16(v1[2], v1[3]);
                    *(u32x4*)(rowp + bj * HALF) = w; } }
    }
};
template <bool BASE_BF16>
struct EpiResidBf {
    static constexpr bool PERM = true, AFTER_DRAIN = false, INIT_ACC = BASE_BF16;
    const void* base; bf16_t* out; int ldc; unsigned char* q8;
    __device__ __forceinline__ void init(f32x4 (&acc)[2][2][4][2], const Unit& u, int wr, int wc, int fr, int fq) const {
        const int row0 = u.pm * BM + wr * 64 + fr, col0 = u.pn * BM + wc * 32 + 8 * fq;
#pragma unroll
        for (int ai = 0; ai < 2; ++ai)
#pragma unroll
            for (int m = 0; m < 4; ++m) { const size_t off = (size_t)(row0 + ai * HALF + m * 16) * ldc + col0;
#pragma unroll
                for (int bj = 0; bj < 2; ++bj) { const u32x4 q = *(const u32x4*)((const bf16_t*)base + off + bj * HALF);
                    acc[ai][bj][m][0] = (f32x4){__uint_as_float(q.x << 16), __uint_as_float(q.x & 0xffff0000u), __uint_as_float(q.y << 16), __uint_as_float(q.y & 0xffff0000u)};
                    acc[ai][bj][m][1] = (f32x4){__uint_as_float(q.z << 16), __uint_as_float(q.z & 0xffff0000u), __uint_as_float(q.w << 16), __uint_as_float(q.w & 0xffff0000u)}; } }
    }
    __device__ __forceinline__ void operator()(const f32x4 (&acc)[2][2][4][2], const Unit& u, int wr, int wc, int fr, int fq, bool based = false) const {
        const int row0 = u.pm * BM + wr * 64 + fr, col0 = u.pn * BM + wc * 32 + 8 * fq, col16 = u.pn * BM + wc * 32 + 16 * (fq >> 1), odd = fq & 1;
#pragma unroll
        for (int ai = 0; ai < 2; ++ai)
#pragma unroll
            for (int p = 0; p < 2; ++p)
#pragma unroll
                for (int bj = 0; bj < 2; ++bj) { unsigned wx[2], wy[2];
#pragma unroll
                    for (int q2 = 0; q2 < 2; ++q2) { const int m = 2 * p + q2; const size_t off = (size_t)(row0 + ai * HALF + m * 16) * ldc + col0;
                        f32x4 b0 = (f32x4){0.f, 0.f, 0.f, 0.f}, b1 = b0;
                        if (based) {} else if (BASE_BF16) { const u32x4 q = *(const u32x4*)((const bf16_t*)base + off + bj * HALF);
                            b0 = (f32x4){__uint_as_float(q.x << 16), __uint_as_float(q.x & 0xffff0000u), __uint_as_float(q.y << 16), __uint_as_float(q.y & 0xffff0000u)};
                            b1 = (f32x4){__uint_as_float(q.z << 16), __uint_as_float(q.z & 0xffff0000u), __uint_as_float(q.w << 16), __uint_as_float(q.w & 0xffff0000u)}; }
                        else { b0 = *(const f32x4*)((const float*)base + off + bj * HALF); b1 = *(const f32x4*)((const float*)base + off + bj * HALF + 4); }
                        const f32x4 v0 = b0 + acc[ai][bj][m][0], v1 = b1 + acc[ai][bj][m][1];
                        u32x4 w; w.x = cvt_pk_bf16(v0[0], v0[1]); w.y = cvt_pk_bf16(v0[2], v0[3]); w.z = cvt_pk_bf16(v1[0], v1[1]); w.w = cvt_pk_bf16(v1[2], v1[3]);
                        *(u32x4*)(out + off + bj * HALF) = w;
                        wx[q2] = pk4_fp8(v0[0], v0[1], v0[2], v0[3], F8_SA); wy[q2] = pk4_fp8(v1[0], v1[1], v1[2], v1[3], F8_SA); }
                    const auto rx = __builtin_amdgcn_permlane16_swap(wx[0], wx[1], false, false); const auto ry = __builtin_amdgcn_permlane16_swap(wy[0], wy[1], false, false);
                    u32x4 w8; w8.x = rx[0]; w8.y = ry[0]; w8.z = rx[1]; w8.w = ry[1];
                    *(u32x4*)(q8 + (size_t)(row0 + ai * HALF + (2 * p + odd) * 16) * ldc + col16 + bj * HALF) = w8; }
    }
};
struct EpiGateUp {
    static constexpr bool PERM = true, AFTER_DRAIN = false, INIT_ACC = false;
    bf16_t* H; const PG8_LAS float* rstab;
    __device__ __forceinline__ void operator()(const f32x4 (&acc)[2][2][4][2], const Unit& u, int wr, int wc, int fr, int fq) const {
        const int row0 = u.pm * BM + wr * 64 + fr, col16 = u.pn * HALF + wc * 32 + 16 * (fq >> 1), odd = fq & 1;
#pragma unroll
        for (int ai = 0; ai < 2; ++ai)
#pragma unroll
            for (int p = 0; p < 2; ++p) { unsigned wx[2], wy[2];
#pragma unroll
                for (int q = 0; q < 2; ++q) { const int m = 2 * p + q; float hv[8]; const float rs = rstab[u.ui * 256 + ai * HALF + wr * 64 + m * 16 + fr];
#pragma unroll
                    for (int n = 0; n < 2; ++n)
#pragma unroll
                        for (int j = 0; j < 4; ++j) { const float g = acc[ai][0][m][n][j] * rs, up = acc[ai][1][m][n][j] * rs;
                            hv[n * 4 + j] = g * __builtin_amdgcn_rcpf(1.f + __builtin_amdgcn_exp2f(-1.4426950408889634f * g)) * up; }
                    wx[q] = pk4_fp8(hv[0], hv[1], hv[2], hv[3], F8_SH); wy[q] = pk4_fp8(hv[4], hv[5], hv[6], hv[7], F8_SH); }
                const auto rx = __builtin_amdgcn_permlane16_swap(wx[0], wx[1], false, false); const auto ry = __builtin_amdgcn_permlane16_swap(wy[0], wy[1], false, false);
                u32x4 w; w.x = rx[0]; w.y = ry[0]; w.z = rx[1]; w.w = ry[1];
                *(u32x4*)((unsigned char*)H + (size_t)(row0 + ai * HALF + (2 * p + odd) * 16) * 512 + col16) = w; }
    }
};
struct EpiBf16Plain {
    static constexpr bool PERM = true, AFTER_DRAIN = false, INIT_ACC = false;
    bf16_t* O; int ldc; float scale;
    __device__ __forceinline__ void operator()(const f32x4 (&acc)[2][2][4][2], const Unit& u, int wr, int wc, int fr, int fq) const {
        const int row0 = u.pm * BM + wr * 64 + fr, col16 = u.pn * BM + wc * 32 + 16 * (fq >> 1), odd = fq & 1;
#pragma unroll
        for (int ai = 0; ai < 2; ++ai)
#pragma unroll
            for (int p = 0; p < 2; ++p)
#pragma unroll
                for (int bj = 0; bj < 2; ++bj) { unsigned wx[2], wy[2];
#pragma unroll
                    for (int q = 0; q < 2; ++q) { const f32x4 v0 = acc[ai][bj][2 * p + q][0], v1 = acc[ai][bj][2 * p + q][1];
                        wx[q] = pk4_fp8(v0[0], v0[1], v0[2], v0[3], scale); wy[q] = pk4_fp8(v1[0], v1[1], v1[2], v1[3], scale); }
                    const auto rx = __builtin_amdgcn_permlane16_swap(wx[0], wx[1], false, false); const auto ry = __builtin_amdgcn_permlane16_swap(wy[0], wy[1], false, false);
                    u32x4 w; w.x = rx[0]; w.y = ry[0]; w.z = rx[1]; w.w = ry[1];
                    *(u32x4*)((unsigned char*)O + (size_t)(row0 + ai * HALF + (2 * p + odd) * 16) * ldc + col16 + bj * HALF) = w; }
    }
};

template <class Epi, class Sched, bool ALIGN_EPI = false, bool SP2 = false, bool GATHER = false, bool FP8 = false>
__device__ __forceinline__ void gemm_phase(PG8_LAS unsigned char* lds, const Gemm g, const Sched& S, const Epi& E) {
    const int tid = threadIdx.x, wid = __builtin_amdgcn_readfirstlane(tid >> 6), lane = tid & 63, wr = wid >> 2, wc = wid & 3, fr = lane & 15, fq = lane >> 4;
    const int K = g.K, nt = K / BK;
    static_assert(!GATHER || SP2, "gather mode is written for the SP2 loop");
    unsigned voffA[2], voffB[2]; int RA[2], CA[2];
#pragma unroll
    for (int i = 0; i < 2; ++i) { int R, C; stage_rc(tid * 16 + i * 8192, R, C); const int Rb = Epi::PERM ? ((R & ~31) + perm32(R & 31)) : R; RA[i] = R; CA[i] = C;
        voffA[i] = (unsigned)(R * K + C) * 2u; voffB[i] = (unsigned)(Rb * K + C) * 2u; }
    unsigned vAc[2][2], vAn[2][2];
#define PG8_ROWS(dst, uidx) do { if constexpr (GATHER) { _Pragma("unroll") for (int h_ = 0; h_ < 2; ++h_) _Pragma("unroll") for (int i_ = 0; i_ < 2; ++i_) \
        dst[h_][i_] = (unsigned)(S.rowidx[(uidx) * 256 + 128 * h_ + RA[i_]] * K + CA[i_]) * 2u; } } while (0)
#define PG8_STAGE_A(bufoff, gb, h, NX) do { if constexpr (GATHER) { unsigned vv_[2] = {(NX) ? vAn[h][0] : vAc[h][0], (NX) ? vAn[h][1] : vAc[h][1]}; PG8_STAGE(bufoff, gb, vv_); } \
        else { PG8_STAGE(bufoff, (gb) + (h) * hstep, voffA); } } while (0)
    const size_t kstep = (size_t)(BK * 2);
    const size_t hstep = (size_t)HALF * K * 2;
    const size_t tstep = 2 * hstep;
    const unsigned ldsw = (unsigned)wid * 1024u;
    const int aoff = lds_byte(wr * 64 + fr, fq * 8), boff = lds_byte(wc * 32 + fr, fq * 8);
#define PG8_SA(b, h) (((b) * 2 + (h)) * HTB)
#define PG8_SB(b, h) ((4 + (b) * 2 + (h)) * HTB)
#define PG8_STAGE(bufoff, gbase, voff) do { _Pragma("unroll") for (int _i = 0; _i < 2; ++_i) \
        __builtin_amdgcn_global_load_lds((const unsigned*)((const char*)(gbase) + (voff)[_i]), (PG8_LAS unsigned*)(lds + (bufoff) + ldsw + _i * 8192), 16, 0, 0); } while (0)
#define PG8_LDA(dst, b, h) do { _Pragma("unroll") for (int m = 0; m < 4; ++m) _Pragma("unroll") for (int k = 0; k < 2; ++k) dst[m][k] = *(const PG8_LAS bf16x8*)(lds + PG8_SA(b, h) + aoff + m * 2048 + k * 1024); } while (0)
#define PG8_LDB(dst, b, h) do { _Pragma("unroll") for (int n = 0; n < 2; ++n) _Pragma("unroll") for (int k = 0; k < 2; ++k) dst[n][k] = *(const PG8_LAS bf16x8*)(lds + PG8_SB(b, h) + boff + n * 2048 + k * 1024); } while (0)
#define PG8_MMA(ai, bj, At, Bt) do { __builtin_amdgcn_s_setprio(1); if constexpr (FP8) { _Pragma("unroll") for (int m = 0; m < 4; ++m) _Pragma("unroll") for (int n = 0; n < 2; ++n) \
        { const v8i_t b8_ = cat8(Bt[n][0], Bt[n][1]), a8_ = cat8(At[m][0], At[m][1]); asm volatile("v_mfma_f32_16x16x128_f8f6f4 %0, %1, %2, %0" : "+v"(acc[ai][bj][m][n]) : "v"(b8_), "v"(a8_)); } } else { \
        _Pragma("unroll") for (int m = 0; m < 4; ++m) _Pragma("unroll") for (int n = 0; n < 2; ++n) _Pragma("unroll") for (int k = 0; k < 2; ++k) \
        acc[ai][bj][m][n] = __builtin_amdgcn_mfma_f32_16x16x32_bf16(Bt[n][k], At[m][k], acc[ai][bj][m][n], 0, 0, 0); } __builtin_amdgcn_s_setprio(0); } while (0)
#define PG8_WAIT_V(n) asm volatile("s_waitcnt vmcnt(" #n ")" ::: "memory")
#define PG8_WAIT_L(n) asm volatile("s_waitcnt lgkmcnt(" #n ")" ::: "memory")
#define PG8_BAR __builtin_amdgcn_s_barrier()
#define PG8_SCHED __builtin_amdgcn_sched_barrier(0)
    Unit cur, nxt; int ui = 0;
    if (!S.next(0, cur)) return;
    f32x4 acc[2][2][4][2]; bool based = false;
    if constexpr (Epi::INIT_ACC) { E.init(acc, cur, wr, wc, fr, fq); based = true; } else {
#pragma unroll
    for (int a = 0; a < 2; ++a)
#pragma unroll
        for (int b = 0; b < 2; ++b)
#pragma unroll
            for (int m = 0; m < 4; ++m)
#pragma unroll
                for (int n = 0; n < 2; ++n) acc[a][b][m][n] = (f32x4){0.f, 0.f, 0.f, 0.f}; }
    bf16x8 At[4][2], B0[2][2], B1[2][2];
    const char* cA = (const char*)g.A + (GATHER ? (size_t)0 : (size_t)cur.pm * tstep); const char* cB = (const char*)g.Bt + (size_t)cur.pb * tstep;
    PG8_ROWS(vAc, 0); PG8_ROWS(vAn, 0);
    S.a_ready(cur);
    if constexpr (SP2) {
        PG8_STAGE(PG8_SB(0, 0), cB, voffB); PG8_STAGE(PG8_SB(0, 1), cB + hstep, voffB); PG8_STAGE_A(PG8_SA(0, 0), cA, 0, false); PG8_STAGE_A(PG8_SA(0, 1), cA, 1, false);
        if (wr == 1) PG8_BAR;
        PG8_WAIT_V(2); PG8_BAR;
        PG8_STAGE(PG8_SB(1, 0), cB + kstep, voffB); PG8_STAGE_A(PG8_SA(1, 0), cA + kstep, 0, false); PG8_STAGE(PG8_SB(1, 1), cB + hstep + kstep, voffB);
        PG8_WAIT_V(6); PG8_BAR;
    } else {
        PG8_STAGE(PG8_SB(0, 0), cB, voffB); PG8_STAGE(PG8_SA(0, 0), cA, voffA); PG8_STAGE(PG8_SB(0, 1), cB + hstep, voffB); PG8_STAGE(PG8_SA(0, 1), cA + hstep, voffA);
        if (wr == 1) PG8_BAR;
        PG8_WAIT_V(4); PG8_BAR;
        PG8_STAGE(PG8_SB(1, 0), cB + kstep, voffB); PG8_STAGE(PG8_SA(1, 0), cA + kstep, voffA); PG8_STAGE(PG8_SB(1, 1), cB + hstep + kstep, voffB);
        PG8_WAIT_V(6); PG8_BAR;
    }
    for (;;) {
        const bool has_next = S.next(ui + 1, nxt);
        if (has_next) PG8_ROWS(vAn, ui + 1);
        const char* nA = has_next ? (const char*)g.A + (GATHER ? (size_t)0 : (size_t)nxt.pm * tstep) : cA; const char* nB = has_next ? (const char*)g.Bt + (size_t)nxt.pb * tstep : cB;
        for (int t = 0; t < nt; t += 2) {
            const bool last = (t == nt - 2);
            const char* a1 = cA + (size_t)(t + 1) * kstep;
            const char* a2 = last ? nA : cA + (size_t)(t + 2) * kstep; const char* b2 = last ? nB : cB + (size_t)(t + 2) * kstep;
            const char* a3 = a2 + kstep; const char* b3 = b2 + kstep;
            if (last && has_next) S.a_ready(nxt);
            if constexpr (SP2) {
            PG8_LDB(B0, 0, 0); PG8_LDB(B1, 0, 1); PG8_SCHED; PG8_LDA(At, 0, 0); PG8_STAGE_A(PG8_SA(1, 1), a1, 1, false);
            PG8_WAIT_V(8); PG8_WAIT_L(0); PG8_BAR; PG8_MMA(0, 0, At, B0); PG8_MMA(0, 1, At, B1); PG8_BAR; PG8_SCHED;
            PG8_LDA(At, 0, 1); PG8_STAGE(PG8_SB(0, 0), b2, voffB); PG8_STAGE(PG8_SB(0, 1), b2 + hstep, voffB); PG8_STAGE_A(PG8_SA(0, 0), a2, 0, last);
            PG8_WAIT_V(8); PG8_WAIT_L(0); PG8_BAR; PG8_MMA(1, 0, At, B0); PG8_MMA(1, 1, At, B1); PG8_BAR; PG8_SCHED;
            PG8_LDB(B0, 1, 0); PG8_LDB(B1, 1, 1); PG8_SCHED; PG8_LDA(At, 1, 0); PG8_STAGE_A(PG8_SA(0, 1), a2, 1, last);
            PG8_WAIT_V(8); PG8_WAIT_L(0); PG8_BAR; PG8_MMA(0, 0, At, B0); PG8_MMA(0, 1, At, B1); PG8_BAR; PG8_SCHED;
            PG8_LDA(At, 1, 1); PG8_STAGE(PG8_SB(1, 0), b3, voffB); PG8_STAGE(PG8_SB(1, 1), b3 + hstep, voffB); PG8_STAGE_A(PG8_SA(1, 0), a3, 0, last);
            PG8_WAIT_V(8); PG8_WAIT_L(0); PG8_BAR; PG8_MMA(1, 0, At, B0); PG8_MMA(1, 1, At, B1); PG8_BAR; PG8_SCHED;
            } else {
            PG8_LDB(B0, 0, 0); PG8_SCHED; PG8_LDA(At, 0, 0); PG8_STAGE(PG8_SA(1, 1), a1 + hstep, voffA);
            PG8_WAIT_L(8); PG8_BAR; PG8_WAIT_L(0); PG8_MMA(0, 0, At, B0); PG8_BAR; PG8_SCHED;
            PG8_LDB(B1, 0, 1); PG8_STAGE(PG8_SB(0, 0), b2, voffB);
            PG8_BAR; PG8_WAIT_L(0); PG8_MMA(0, 1, At, B1); PG8_BAR;
            PG8_LDA(At, 0, 1); PG8_STAGE(PG8_SA(0, 0), a2, voffA);
            PG8_BAR; PG8_WAIT_L(0); PG8_MMA(1, 0, At, B0); PG8_BAR; PG8_SCHED;
            PG8_STAGE(PG8_SB(0, 1), b2 + hstep, voffB);
            PG8_WAIT_V(6); PG8_BAR; PG8_MMA(1, 1, At, B1); PG8_BAR;
            PG8_LDB(B0, 1, 0); PG8_SCHED; PG8_LDA(At, 1, 0); PG8_STAGE(PG8_SA(0, 1), a2 + hstep, voffA);
            PG8_WAIT_L(8); PG8_BAR; PG8_WAIT_L(0); PG8_MMA(0, 0, At, B0); PG8_BAR; PG8_SCHED;
            PG8_LDB(B1, 1, 1); PG8_STAGE(PG8_SB(1, 0), b3, voffB);
            PG8_BAR; PG8_WAIT_L(0); PG8_MMA(0, 1, At, B1); PG8_BAR;
            PG8_LDA(At, 1, 1); PG8_STAGE(PG8_SA(1, 0), a3, voffA);
            PG8_BAR; PG8_WAIT_L(0); PG8_MMA(1, 0, At, B0); PG8_BAR; PG8_SCHED;
            PG8_STAGE(PG8_SB(1, 1), b3 + hstep, voffB);
            PG8_WAIT_V(6); PG8_BAR; PG8_MMA(1, 1, At, B1); PG8_BAR;
            }
        }
        if constexpr (ALIGN_EPI) { if (wr == 0) PG8_BAR; }
        if constexpr (FP8) asm volatile("s_nop 15\n\ts_nop 15\n\ts_nop 15" ::: "memory");
        if constexpr (!Epi::AFTER_DRAIN) { if constexpr (Epi::INIT_ACC) { E(acc, cur, wr, wc, fr, fq, based); based = false; } else E(acc, cur, wr, wc, fr, fq); S.done(cur); }
        if (!has_next) break;
#pragma unroll
        for (int a = 0; a < 2; ++a)
#pragma unroll
            for (int b = 0; b < 2; ++b)
#pragma unroll
                for (int m = 0; m < 4; ++m)
#pragma unroll
                    for (int n = 0; n < 2; ++n) acc[a][b][m][n] = (f32x4){0.f, 0.f, 0.f, 0.f};
        cur = nxt; cA = nA; cB = nB; ++ui;
        if constexpr (GATHER) { _Pragma("unroll") for (int h_ = 0; h_ < 2; ++h_) _Pragma("unroll") for (int i_ = 0; i_ < 2; ++i_) vAc[h_][i_] = vAn[h_][i_]; }
        if constexpr (ALIGN_EPI) { if (wr == 1) PG8_BAR; }
    }
    PG8_WAIT_V(0);
    if constexpr (!ALIGN_EPI) { if (wr == 0) PG8_BAR; }
    PG8_BAR;
    if constexpr (Epi::AFTER_DRAIN) { E.fused(acc, cur, wr, wc, fr, fq, lds, wid, lane); S.done(cur); }
#undef PG8_SA
#undef PG8_SB
#undef PG8_STAGE
#undef PG8_STAGE_A
#undef PG8_ROWS
#undef PG8_LDA
#undef PG8_LDB
#undef PG8_MMA
#undef PG8_WAIT_V
#undef PG8_WAIT_L
#undef PG8_BAR
#undef PG8_SCHED
}
}
namespace att {
typedef unsigned short bf16;
typedef short bf16x8 __attribute__((ext_vector_type(8)));
typedef short s16x4 __attribute__((ext_vector_type(4)));
typedef float f32x16 __attribute__((ext_vector_type(16)));
typedef float f32x4 __attribute__((ext_vector_type(4)));
typedef unsigned u32x4 __attribute__((ext_vector_type(4)));
typedef unsigned u32x2 __attribute__((ext_vector_type(2)));
#define ALAS __attribute__((address_space(3)))
constexpr int SEQ = 2048, NH = 16, DM = 1024, QB = 256, KVB = 64;
constexpr int SLOTB = 8192, L_K = 0, L_V = 2 * SLOTB, L_CB = 4 * SLOTB, L_WT = L_CB + SEQ * 4, L_ST = L_WT + 256, STG_ROW = 144, LDS_BYTES = L_ST + 8 * 32 * STG_ROW;
constexpr float C2 = 0.125f * 1.4426950408889634f;
__device__ __forceinline__ int crow(int r, int hi) { return (r & 3) + 8 * (r >> 2) + 4 * hi; }
__device__ __forceinline__ void glds16(const void* gsrc, unsigned lds_dst) { unsigned keep;
    asm volatile("s_mov_b32 %0, m0\n\ts_mov_b32 m0, %2\n\ts_nop 0\n\tglobal_load_lds_dwordx4 %1, off\n\ts_mov_b32 m0, %0" : "=&s"(keep) : "v"(gsrc), "s"(lds_dst) : "memory"); }
typedef float f32x2_t __attribute__((ext_vector_type(2))); typedef __bf16 bf16x2_t __attribute__((ext_vector_type(2)));
__device__ __forceinline__ unsigned cvtpk(float lo, float hi) { f32x2_t v = {lo, hi}; bf16x2_t b = __builtin_convertvector(v, bf16x2_t); return __builtin_bit_cast(unsigned, b); }
typedef short v4i16_t __attribute__((ext_vector_type(4)));
__device__ __forceinline__ s16x4 vtr(const ALAS char* p) { return __builtin_bit_cast(s16x4, __builtin_amdgcn_ds_read_tr16_b64_v4i16((ALAS v4i16_t*)p)); }
__device__ __forceinline__ float swap_other_mul(float x) { auto rr = __builtin_amdgcn_permlane32_swap(__float_as_uint(x), __float_as_uint(x), false, false); return __uint_as_float(rr[0]) * __uint_as_float(rr[1]); }

__device__ __forceinline__ void sb_wave_unit(int b, int h, int R0, const bf16* Q, const bf16* K, const bf16* V, bf16* O, ALAS char* wl) {
    int lane_ = threadIdx.x & 63; asm volatile("" : "+v"(lane_)); const int lane = lane_, r32 = lane & 31, hi = lane >> 5;
    const long rowbase = (long)b * SEQ;
    const bf16* Qw = Q + (rowbase + R0) * DM + h * 64;
    const bf16* Kh = K + rowbase * DM + h * 64; const bf16* Vh = V + rowbase * DM + h * 64;
    const unsigned lk = (unsigned)__builtin_amdgcn_readfirstlane((unsigned)(size_t)wl), lv = lk + 8192u;
    const int dkey = lane >> 3, dj = lane & 7;
#define SB_DMA_K(kb_) do { _Pragma("unroll") for (int p_ = 0; p_ < 8; ++p_) { const int kl_ = 8 * p_ + dkey; int key_ = (kb_) + kl_; key_ = key_ < 0 ? 0 : key_; \
        glds16(Kh + (long)key_ * DM + (dj ^ ((kl_ >> 1) & 7)) * 8, lk + p_ * 1024u); } } while (0)
#define SB_DMA_V(kb_) do { _Pragma("unroll") for (int p_ = 0; p_ < 8; ++p_) { const int kl_ = 8 * p_ + dkey; int key_ = (kb_) + kl_; key_ = key_ < 0 ? 0 : key_; \
        glds16(Vh + (long)key_ * DM + (dj ^ (4 * ((kl_ >> 1) & 1))) * 8, lv + p_ * 1024u); } } while (0)
    bf16x8 qr[4];
#pragma unroll
    for (int d0 = 0; d0 < 4; ++d0) qr[d0] = *reinterpret_cast<const bf16x8*>(&Qw[(long)r32 * DM + d0 * 16 + hi * 8]);
    int kb = R0 - 32;
    SB_DMA_K(kb); SB_DMA_V(kb);
    f32x16 o[2]; o[0] = f32x16{}; o[1] = f32x16{};
    float carry = 1.f;
    const int trow = R0 + r32;
    const ALAS char* kp = wl + r32 * 128; const int ksw = (r32 >> 1) & 7;
    int koff[4];
#pragma unroll
    for (int d0 = 0; d0 < 4; ++d0) koff[d0] = ((2 * d0 + hi) ^ ksw) * 16;
    const int vq = (lane & 15) >> 2, vpp = lane & 3, vsw = 4 * ((vq >> 1) & 1);
    const ALAS char* vpb[2];
#pragma unroll
    for (int d0 = 0; d0 < 2; ++d0) vpb[d0] = wl + 8192 + (4 * hi + vq) * 128 + (((4 * d0) ^ vsw) + 2 * ((lane >> 4) & 1) + (vpp >> 1)) * 16 + 8 * (vpp & 1);
    for (;;) {
        asm volatile("s_waitcnt vmcnt(8)" ::: "memory");
        f32x16 p0, p1;
#pragma unroll
        for (int d0 = 0; d0 < 4; ++d0) {
            const bf16x8 k0 = *(const ALAS bf16x8*)(kp + koff[d0]), k1 = *(const ALAS bf16x8*)(kp + koff[d0] + 4096);
            if (d0 == 0) { p0 = __builtin_amdgcn_mfma_f32_32x32x16_bf16(k0, qr[0], f32x16{}, 0, 0, 0); p1 = __builtin_amdgcn_mfma_f32_32x32x16_bf16(k1, qr[0], f32x16{}, 0, 0, 0); }
            else { p0 = __builtin_amdgcn_mfma_f32_32x32x16_bf16(k0, qr[d0], p0, 0, 0, 0); p1 = __builtin_amdgcn_mfma_f32_32x32x16_bf16(k1, qr[d0], p1, 0, 0, 0); }
        }
        const int kbn = kb - 64; const bool more = (kbn + 63 >= 0);
        asm volatile("s_waitcnt lgkmcnt(0)" ::: "memory");
        if (more) SB_DMA_K(kbn);
        f32x16 n0, n1;
#pragma unroll
        for (int r = 0; r < 16; ++r) {
            { const float z = __builtin_fmaxf(p0[r], -100.f), e = __builtin_amdgcn_exp2f(-z), rr = __builtin_amdgcn_rcpf(1.f + e); p0[r] = rr; n0[r] = e * rr; }
            { const float z = __builtin_fmaxf(p1[r], -100.f), e = __builtin_amdgcn_exp2f(-z), rr = __builtin_amdgcn_rcpf(1.f + e); p1[r] = rr; n1[r] = e * rr; }
        }
        if (kb + 63 >= R0 || kb < 0) {
#pragma unroll
            for (int r = 0; r < 16; ++r) { const int kv = kb + crow(r, hi);
                if (kv >= trow || kv < 0) { p0[r] = 0.f; n0[r] = 1.f; }
                if (kv + 32 >= trow || kv + 32 < 0) { p1[r] = 0.f; n1[r] = 1.f; } }
        }
        float G[8], i2[8], i1[8], i0[8];
#pragma unroll
        for (int g = 0; g < 4; ++g) { i2[g] = n0[4 * g + 3]; i1[g] = i2[g] * n0[4 * g + 2]; i0[g] = i1[g] * n0[4 * g + 1]; G[g] = i0[g] * n0[4 * g];
                                      i2[4 + g] = n1[4 * g + 3]; i1[4 + g] = i2[4 + g] * n1[4 * g + 2]; i0[4 + g] = i1[4 + g] * n1[4 * g + 1]; G[4 + g] = i0[4 + g] * n1[4 * g]; }
        float run = carry;
#pragma unroll
        for (int g = 7; g >= 0; --g) {
            auto rr = __builtin_amdgcn_permlane32_swap(__float_as_uint(G[g]), __float_as_uint(G[g]), false, false);
            const float other = hi ? 1.f : __uint_as_float(rr[1]);
            const float T = __uint_as_float(rr[0]) * __uint_as_float(rr[1]);
            const float af = run * other; run *= T;
            if (g < 4) { p0[4 * g + 3] *= af; p0[4 * g + 2] *= af * i2[g]; p0[4 * g + 1] *= af * i1[g]; p0[4 * g] *= af * i0[g]; }
            else { const int gg = g - 4; p1[4 * gg + 3] *= af; p1[4 * gg + 2] *= af * i2[g]; p1[4 * gg + 1] *= af * i1[g]; p1[4 * gg] *= af * i0[g]; }
        }
        carry = run;
        u32x4 pw[4];
#pragma unroll
        for (int j = 0; j < 4; ++j) { pw[0][j] = cvtpk(p0[2 * j], p0[2 * j + 1]); pw[1][j] = cvtpk(p0[8 + 2 * j], p0[8 + 2 * j + 1]); pw[2][j] = cvtpk(p1[2 * j], p1[2 * j + 1]); pw[3][j] = cvtpk(p1[8 + 2 * j], p1[8 + 2 * j + 1]); }
        if (more) asm volatile("s_waitcnt vmcnt(8)" ::: "memory"); else asm volatile("s_waitcnt vmcnt(0)" ::: "memory");
#pragma unroll
        for (int d0 = 0; d0 < 2; ++d0)
#pragma unroll
            for (int kq = 0; kq < 4; ++kq) { const s16x4 lo = vtr(vpb[d0] + kq * 2048), hh = vtr(vpb[d0] + kq * 2048 + 1024);
                const bf16x8 vf = (bf16x8){lo[0], lo[1], lo[2], lo[3], hh[0], hh[1], hh[2], hh[3]};
                o[d0] = __builtin_amdgcn_mfma_f32_32x32x16_bf16(vf, __builtin_bit_cast(bf16x8, pw[kq]), o[d0], 0, 0, 0); }
        if (!more || __all(carry == 0.f)) break;
        asm volatile("s_waitcnt lgkmcnt(0)" ::: "memory");
        SB_DMA_V(kbn);
        kb = kbn;
    }
    asm volatile("s_waitcnt vmcnt(0) lgkmcnt(0)" ::: "memory");
#undef SB_DMA_K
#undef SB_DMA_V
    ALAS char* stg = wl;
#pragma unroll
    for (int d0 = 0; d0 < 2; ++d0)
#pragma unroll
        for (int g = 0; g < 4; ++g) { u32x2 w; w.x = cvtpk(o[d0][4 * g], o[d0][4 * g + 1]); w.y = cvtpk(o[d0][4 * g + 2], o[d0][4 * g + 3]);
            *(ALAS u32x2*)(stg + r32 * STG_ROW + (32 * d0 + 8 * g + 4 * hi) * 2) = w; }
    asm volatile("s_waitcnt lgkmcnt(0)" ::: "memory");
    bf16* Ow = O + (rowbase + R0) * DM + h * 64;
#pragma unroll
    for (int i = 0; i < 4; ++i) { const int row = i * 8 + (lane >> 3), ch = lane & 7; const u32x4 v = *(const ALAS u32x4*)(stg + row * STG_ROW + ch * 16); *(u32x4*)(Ow + (long)row * DM + ch * 8) = v; }
    asm volatile("s_waitcnt vmcnt(0) lgkmcnt(0)" ::: "memory");
}
template <class Hook>
__device__ __forceinline__ void sb_phase(ALAS char* lds, int vcu, int G, const bf16* Q, const bf16* K, const bf16* V, bf16* O, Hook hook) {
    const int wid = __builtin_amdgcn_readfirstlane(threadIdx.x >> 6);
    int hi_ = 0;
    for (int v = vcu; v < 256; v += G) {
        const int bh = v >> 1, s = v & 1;
#pragma unroll 1
        for (int i = 0; i < 4; ++i) { const int qb = s ? (i == 0 ? 2 : i == 1 ? 5 : i == 2 ? 3 : 4) : (i == 0 ? 0 : i == 1 ? 7 : i == 2 ? 1 : 6);
            if (wid >= 4) hook(hi_, lds + wid * 16384);
            sb_wave_unit(bh / NH, bh % NH, qb * QB + wid * 32, Q, K, V, O, lds + wid * 16384);
            if (wid < 4) hook(hi_, lds + wid * 16384);
            ++hi_; }
    }
    for (; hi_ < 4; ++hi_) hook(hi_, lds + wid * 16384);
}
}
namespace fatt {
using bf16=__hip_bfloat16;
using bf16x8=__attribute__((ext_vector_type(8)))short;
using s16x4=__attribute__((ext_vector_type(4)))short;
using f32x16=__attribute__((ext_vector_type(16)))float;
using u32x4=__attribute__((ext_vector_type(4)))unsigned;
using f32x4v=__attribute__((ext_vector_type(4)))float;
constexpr int BATCH=8,NHEAD=16,SEQ=2048,D=64,DM=NHEAD*D;
constexpr int NW=8,QBLK=32,QB=QBLK*NW,KVBLK=64,NQB=SEQ/QB;
constexpr int ATTN_PITCH=DM, ATTN_UNIT_ROWS=QB;
__device__ __forceinline__ int crow(int r,int hi){return (r&3)+8*(r>>2)+4*hi;}
#define SBAR() __builtin_amdgcn_sched_barrier(0)
__device__ __forceinline__ void cmask(f32x16&p0,f32x16&p1,int jb,int qrel,int hi){
  const float NEG=-INFINITY; int kb=64*jb+4*hi;
  #pragma unroll
  for(int r=0;r<16;++r){int kv=kb+(r&3)+8*(r>>2); if(kv>qrel)p0[r]=NEG; if(kv+32>qrel)p1[r]=NEG;}
}

constexpr int NSLOT=3, SLOTB=8192;
constexpr int LDS_K=0, LDS_V=NSLOT*SLOTB, LDS_WS=2*NSLOT*SLOTB, LDS_OST=LDS_WS+NW*64*4, LDS_CB=LDS_OST+NW*4096, LDS_SC=LDS_CB+SEQ*4, LDS_BYTES=LDS_SC+64;
constexpr float C2=0.125f*1.4426950408889634f;
__device__ __forceinline__ void glds16(const void*gsrc,unsigned lds_dst){unsigned keep;
  asm volatile("s_mov_b32 %0, m0\n\ts_mov_b32 m0, %2\n\ts_nop 0\n\tglobal_load_lds_dwordx4 %1, off\n\ts_mov_b32 m0, %0":"=&s"(keep):"v"(gsrc),"s"(lds_dst):"memory");}
__device__ __forceinline__ float max3f(float a,float b,float c){float r;asm("v_max3_f32 %0, %1, %2, %3":"=v"(r):"v"(a),"v"(b),"v"(c));return r;}
__device__ __forceinline__ float max2f(float a,float b){float r;asm("v_max_f32_e32 %0, %1, %2":"=v"(r):"v"(a),"v"(b));return r;}
__device__ __forceinline__ float fadd_s(float a,float b){float r;asm("v_add_f32_e32 %0, %1, %2":"=v"(r):"v"(a),"v"(b));return r;}
__device__ __forceinline__ float fsub_s(float a,float b){float r;asm("v_sub_f32_e32 %0, %1, %2":"=v"(r):"v"(a),"v"(b));return r;}
typedef float f32x2_t __attribute__((ext_vector_type(2))); typedef __bf16 bf16x2_t __attribute__((ext_vector_type(2)));
__device__ __forceinline__ unsigned cvtpk_s(float lo,float hi){f32x2_t v={lo,hi};bf16x2_t b=__builtin_convertvector(v,bf16x2_t);return __builtin_bit_cast(unsigned,b);}
#define WAIT_BAR(N) asm volatile("s_waitcnt vmcnt(" #N ") lgkmcnt(0)\n\ts_barrier":::"memory")

__device__ __forceinline__ void qkt(f32x16&p0,f32x16&p1,const char*Kslot,const bf16x8*qr,int r32,int hi){
  const char*kb=Kslot+hi*1024+r32*16;
  #pragma unroll
  for(int d0=0;d0<4;++d0){
    const bf16x8 b0=*reinterpret_cast<const bf16x8*>(kb+d0*2048);
    const bf16x8 b1=*reinterpret_cast<const bf16x8*>(kb+d0*2048+512);
    p0=__builtin_amdgcn_mfma_f32_32x32x16_bf16(b0,qr[d0],p0,0,0,0);p1=__builtin_amdgcn_mfma_f32_32x32x16_bf16(b1,qr[d0],p1,0,0,0);}
}
typedef __attribute__((address_space(3))) const char* lds_cptr;
typedef short v4i16_t __attribute__((ext_vector_type(4)));
__device__ __forceinline__ void kload8(bf16x8*kf,lds_cptr kp){
  kf[0]=*(const __attribute__((address_space(3))) bf16x8*)(kp);      kf[1]=*(const __attribute__((address_space(3))) bf16x8*)(kp+512);
  kf[2]=*(const __attribute__((address_space(3))) bf16x8*)(kp+2048); kf[3]=*(const __attribute__((address_space(3))) bf16x8*)(kp+2560);
  kf[4]=*(const __attribute__((address_space(3))) bf16x8*)(kp+4096); kf[5]=*(const __attribute__((address_space(3))) bf16x8*)(kp+4608);
  kf[6]=*(const __attribute__((address_space(3))) bf16x8*)(kp+6144); kf[7]=*(const __attribute__((address_space(3))) bf16x8*)(kp+6656);
}
__device__ __forceinline__ void kload2(bf16x8*kf,lds_cptr kp,int j){ kf[2*j]=*(const __attribute__((address_space(3))) bf16x8*)(kp+j*2048); kf[2*j+1]=*(const __attribute__((address_space(3))) bf16x8*)(kp+j*2048+512); }
__device__ __forceinline__ s16x4 vtr(lds_cptr p){ return __builtin_bit_cast(s16x4,__builtin_amdgcn_ds_read_tr16_b64_v4i16((__attribute__((address_space(3))) v4i16_t*)p)); }
__device__ __forceinline__ float rowmax(const f32x16&p0,const f32x16&p1){
  float a=max3f(p0[0],p0[1],p1[0]),b=max3f(p0[2],p0[3],p1[1]);a=max3f(a,p1[2],p1[3]);
  #pragma unroll
  for(int r=4;r<16;r+=4){a=max3f(a,p0[r],p0[r+1]);b=max3f(b,p0[r+2],p0[r+3]);a=max3f(a,p1[r],p1[r+1]);b=max3f(b,p1[r+2],p1[r+3]);}
  const float m=max2f(a,b);
  auto rr=__builtin_amdgcn_permlane32_swap(__float_as_uint(m),__float_as_uint(m),false,false);
  return max2f(__uint_as_float(rr[0]),__uint_as_float(rr[1]));
}
__device__ __forceinline__ void pv(f32x16*o,int vb,bf16x8 pa0,bf16x8 pa1,bf16x8 pa2,bf16x8 pa3){
  #pragma unroll
  for(int d0=0;d0<2;++d0){s16x4 lo[4],hi[4];
    #pragma unroll
    for(int ks=0;ks<4;++ks){
      asm volatile("ds_read_b64_tr_b16 %0,%1 offset:%c2":"=&v"(lo[ks]):"v"(vb),"i"(d0*4096+ks*1024):"memory");
      asm volatile("ds_read_b64_tr_b16 %0,%1 offset:%c2":"=&v"(hi[ks]):"v"(vb),"i"(d0*4096+ks*1024+512):"memory");}
    asm volatile("s_waitcnt lgkmcnt(0)":::"memory");SBAR();
    #define PK(k) (bf16x8){lo[k][0],lo[k][1],lo[k][2],lo[k][3],hi[k][0],hi[k][1],hi[k][2],hi[k][3]}
    o[d0]=__builtin_amdgcn_mfma_f32_32x32x16_bf16(pa0,PK(0),o[d0],0,0,0);
    o[d0]=__builtin_amdgcn_mfma_f32_32x32x16_bf16(pa1,PK(1),o[d0],0,0,0);
    o[d0]=__builtin_amdgcn_mfma_f32_32x32x16_bf16(pa2,PK(2),o[d0],0,0,0);
    o[d0]=__builtin_amdgcn_mfma_f32_32x32x16_bf16(pa3,PK(3),o[d0],0,0,0);
    #undef PK
  }
}

#ifndef ATTN_STORE16
#define ATTN_STORE16(p,v) (*(u32x4*)(p)=(v))
#endif
template<int THRL> __device__ __forceinline__ void attn_unit(int b,int h,int qb,const bf16*Q,const bf16*__restrict__ K,const bf16*__restrict__ V,bf16*O,const float*logf,char*shm){
  int tid_=threadIdx.x; asm volatile("":"+v"(tid_));
  const int tid=tid_,lane=tid&63,r32=lane&31,hi=lane>>5; const int wid=__builtin_amdgcn_readfirstlane(tid>>6);
  const long rowbase=(long)b*SEQ; const int q0=qb*QB;
  const int NT=(q0+QB)/KVBLK;
  const bf16*Qw=Q+(rowbase+q0+wid*QBLK)*DM+h*D;
  const bf16*Kh=K+rowbase*DM+h*D,*Vh=V+rowbase*DM+h*D;
  const unsigned lds0=(unsigned)(uintptr_t)shm;
  float*wsf=(float*)(shm+LDS_WS)+wid*64;
  const bf16*ksrc=Kh+(long)lane*DM+wid*8;
  const bf16*vsrc=Vh+(long)(16*(wid&3)+(lane>>2))*DM+(wid>>2)*32+(lane&3)*8;
  const unsigned kdst=lds0+LDS_K+wid*1024, vdst=lds0+LDS_V+wid*1024;
  #define DMA_K(t,slot) glds16(ksrc+(long)(NT-1-(t))*KVBLK*DM,(unsigned)__builtin_amdgcn_readfirstlane(kdst+(slot)))
  #define DMA_V(t,slot) glds16(vsrc+(long)(NT-1-(t))*KVBLK*DM,(unsigned)__builtin_amdgcn_readfirstlane(vdst+(slot)))
  const int vb0=(int)(lds0+LDS_V)+((lane>>4)&1)*32+(lane&3)*8+(4*hi+((lane&15)>>2))*64;
  const char*Kbase=shm+LDS_K; bf16x8 kf[8];
  const lds_cptr shm3=(lds_cptr)shm; const lds_cptr kp0=shm3+LDS_K+hi*1024+r32*16; const lds_cptr vp0=shm3+LDS_V+((lane>>4)&1)*32+(lane&3)*8+(4*hi+((lane&15)>>2))*64;
  DMA_K(0,0);DMA_V(0,0);DMA_K(1,SLOTB);
  bf16x8 qr[4];
  #pragma unroll
  for(int d0=0;d0<4;++d0)qr[d0]=*reinterpret_cast<const bf16x8*>(&Qw[(long)r32*DM+d0*16+hi*8]);
  typedef __attribute__((address_space(3))) float* lds_fptr; typedef __attribute__((address_space(3))) f32x4v* lds_f4ptr;
  const lds_fptr cb3=(lds_fptr)(shm+LDS_CB);
  const float ct2=cb3[q0+wid*QBLK+r32];
  const int tstart=3-(wid>>1);
  #define BIAS(C0,C1,t) do{ const float cm_=ct2-mhat; const lds_f4ptr cp_=(lds_f4ptr)cb3+(((NT-1-(t))*KVBLK)>>2)+hi; \
    _Pragma("unroll") for(int g_=0;g_<4;++g_){ const f32x4v a_=cp_[2*g_], c_=cp_[8+2*g_]; \
      _Pragma("unroll") for(int j_=0;j_<4;++j_){ C0[4*g_+j_]=cm_-a_[j_]; C1[4*g_+j_]=cm_-c_[j_]; } } }while(0)
  float mhat=0.f,l_reg=0.f;f32x16 o[2];o[0]=f32x16{};o[1]=f32x16{};
  const int qrel=wid*QBLK+r32;
  #define CMASK(P0,P1,t) do{int jb_=3-(t); if(jb_>=0)cmask(P0,P1,jb_,qrel,hi);}while(0)
  bool resc=false;
  #define DECIDE(C0,C1,t,rm) do{ resc=false; const bool st_=((t)==tstart); \
    if(st_||__builtin_expect(__any((rm)>(float)THRL),0)){ const float dl=st_?(rm):__builtin_fmaxf((rm),0.f); mhat+=dl; \
      _Pragma("unroll") for(int r=0;r<16;++r){C0[r]-=dl;C1[r]-=dl;} \
      if(!st_){ const float f=__builtin_amdgcn_exp2f(-dl); l_reg*=f; if(hi==0)wsf[r32]=f; resc=true; } } }while(0)
  #define RESC() do{ if(resc){ asm volatile("s_waitcnt lgkmcnt(0)":::"memory"); \
      _Pragma("unroll") for(int d_=0;d_<2;++d_) _Pragma("unroll") for(int r=0;r<16;++r)o[d_][r]*=wsf[crow(r,hi)]; } }while(0)
  f32x16 pA0,pA1,pB0,pB1;
  int sl_prev=0,sl_cur=0,sl_next=SLOTB;
  #define ROT() do{sl_prev=sl_cur;sl_cur=sl_next;sl_next=(sl_next==(NSLOT-1)*SLOTB)?0:sl_next+SLOTB;}while(0)
  DMA_K(2,2*SLOTB);
  WAIT_BAR(3);
  BIAS(pA0,pA1,0);
  qkt(pA0,pA1,Kbase,qr,r32,hi);asm volatile("s_nop 15\n\ts_nop 7":"+v"(pA0),"+v"(pA1));CMASK(pA0,pA1,0);
  { const float rm0=rowmax(pA0,pA1); DECIDE(pA0,pA1,0,rm0); }
  BIAS(pB0,pB1,1);
  _Pragma("unroll") for(int r=0;r<16;++r){pA0[r]=__builtin_amdgcn_exp2f(pA0[r]);pA1[r]=__builtin_amdgcn_exp2f(pA1[r]);}
  WAIT_BAR(0);
  DMA_K(3,0);DMA_V(1,SLOTB);
  ROT();
  kload8(kf,kp0+sl_cur);
  WAIT_BAR(2);
  s16x4 vlo[8],vhi[8]; u32x4 pw0,pw1,pw2,pw3;
  #define PKW(P,B) cvtpk_s(P[B],P[B+1])
  #define PAF(k) __builtin_bit_cast(bf16x8,pw##k)
  #define VFR(i) (bf16x8){vlo[i][0],vlo[i][1],vlo[i][2],vlo[i][3],vhi[i][0],vhi[i][1],vhi[i][2],vhi[i][3]}
  #define PIN(x) asm volatile("":"+v"(x))
  #define MX3(a,b,c) __builtin_fmaxf(__builtin_fmaxf((a),(b)),(c))
  #define GAPA(MF,A0,A1,A2,A3,W0,W1,PW) do{ MF; sacc+=A0; sacc+=A1; sacc+=A2; sacc+=A3; PIN(sacc); W0; W1; PIN(PW); SBAR(); }while(0)
  #define EX(v) __builtin_amdgcn_exp2f(v)
  #define GAPB(MF,X,B,K_,TR,TW,GLF,PN0,PN1) do{ MF; X[B]=EX(X[B]); X[B+1]=EX(X[B+1]); X[B+2]=EX(X[B+2]); X[B+3]=EX(X[B+3]); PIN(X); \
    if(GLF){ if((K_)<7){TW=cp_[((K_)+1)<4?2*((K_)+1):8+2*((K_)-3)];} \
      if((K_)<4){ PN0[4*((K_)&3)]=cm_-TR[0]; PN0[4*((K_)&3)+1]=cm_-TR[1]; PN0[4*((K_)&3)+2]=cm_-TR[2]; PN0[4*((K_)&3)+3]=cm_-TR[3]; } \
      else { PN1[4*((K_)&3)]=cm_-TR[0]; PN1[4*((K_)&3)+1]=cm_-TR[1]; PN1[4*((K_)&3)+2]=cm_-TR[2]; PN1[4*((K_)&3)+3]=cm_-TR[3]; } } SBAR(); }while(0)
  #define VRD(i) do{ vlo[i]=vtr(vp_+(((i)>>2)*4096+((i)&3)*1024)); vhi[i]=vtr(vp_+(((i)>>2)*4096+((i)&3)*1024+512)); }while(0)
  #define KRD(G,j) do{ if(G){ kload2(kf,kp0+sl_next,j); SBAR(); } }while(0)
  #define STEP(C0,C1,P0,P1,t,GK,GV,GL) do{ SBAR(); \
    const lds_cptr vp_=vp0+sl_prev; \
    VRD(0); SBAR(); float sacc=(P0[0]+P0[1]); \
    GAPA(C0=__builtin_amdgcn_mfma_f32_32x32x16_bf16(kf[0],qr[0],C0,0,0,0), P0[2],P0[3],P0[4],P0[5],     pw0[0]=PKW(P0,0), pw0[1]=PKW(P0,2), pw0); \
    VRD(4); SBAR(); GAPA(C1=__builtin_amdgcn_mfma_f32_32x32x16_bf16(kf[1],qr[0],C1,0,0,0), P0[6],P0[7],P0[8],P0[9],     pw0[2]=PKW(P0,4), pw0[3]=PKW(P0,6), pw0); \
    VRD(1); SBAR(); GAPA(C0=__builtin_amdgcn_mfma_f32_32x32x16_bf16(kf[2],qr[1],C0,0,0,0),   P0[10],P0[11],P0[12],P0[13], pw1[0]=PKW(P0,8), pw1[1]=PKW(P0,10), pw1); \
    VRD(5); SBAR(); GAPA(C1=__builtin_amdgcn_mfma_f32_32x32x16_bf16(kf[3],qr[1],C1,0,0,0),   P0[14],P0[15],P1[0],P1[1],   pw1[2]=PKW(P0,12),pw1[3]=PKW(P0,14), pw1); \
    VRD(2); SBAR(); GAPA(C0=__builtin_amdgcn_mfma_f32_32x32x16_bf16(kf[4],qr[2],C0,0,0,0),   P1[2],P1[3],P1[4],P1[5],     pw2[0]=PKW(P1,0), pw2[1]=PKW(P1,2), pw2); \
    VRD(6); SBAR(); GAPA(C1=__builtin_amdgcn_mfma_f32_32x32x16_bf16(kf[5],qr[2],C1,0,0,0),   P1[6],P1[7],P1[8],P1[9],     pw2[2]=PKW(P1,4), pw2[3]=PKW(P1,6), pw2); \
    VRD(3); SBAR(); GAPA(C0=__builtin_amdgcn_mfma_f32_32x32x16_bf16(kf[6],qr[3],C0,0,0,0),   P1[10],P1[11],P1[12],P1[13], pw3[0]=PKW(P1,8), pw3[1]=PKW(P1,10), pw3); \
    VRD(7); SBAR(); GAPA(C1=__builtin_amdgcn_mfma_f32_32x32x16_bf16(kf[7],qr[3],C1,0,0,0),   P1[14],P1[15],0.f,0.f,       pw3[2]=PKW(P1,12),pw3[3]=PKW(P1,14), pw3); \
    l_reg+=sacc; \
    if(GK){DMA_K((t)+3,sl_cur);} if(GV){DMA_V((t)+1,sl_next);} \
    CMASK(C0,C1,t); \
    { float a=MX3(C0[0],C0[1],C1[0]),b=MX3(C0[2],C0[3],C1[1]); a=MX3(a,C1[2],C1[3]); \
      _Pragma("unroll") for(int r=4;r<16;r+=4){a=MX3(a,C0[r],C0[r+1]);b=MX3(b,C0[r+2],C0[r+3]);a=MX3(a,C1[r],C1[r+1]);b=MX3(b,C1[r+2],C1[r+3]);} \
      float rm=__builtin_fmaxf(a,b); { auto rr=__builtin_amdgcn_permlane32_swap(__float_as_uint(rm),__float_as_uint(rm),false,false); rm=__builtin_fmaxf(__uint_as_float(rr[0]),__uint_as_float(rr[1])); } \
      DECIDE(C0,C1,t,rm); } \
    const float cm_=ct2-mhat; const lds_f4ptr cp_=(lds_f4ptr)cb3+(((NT-2-(t))*KVBLK)>>2)+hi; f32x4v tbA=f32x4v{},tbB=f32x4v{}; if(GL){tbA=cp_[0];} \
    SBAR(); \
    GAPB(o[0]=__builtin_amdgcn_mfma_f32_32x32x16_bf16(PAF(0),VFR(0),o[0],0,0,0), C0,0, 0,tbA,tbB,GL,P0,P1); \
    GAPB(o[1]=__builtin_amdgcn_mfma_f32_32x32x16_bf16(PAF(0),VFR(4),o[1],0,0,0), C0,4, 1,tbB,tbA,GL,P0,P1); \
    KRD(GL,0); GAPB(o[0]=__builtin_amdgcn_mfma_f32_32x32x16_bf16(PAF(1),VFR(1),o[0],0,0,0), C0,8, 2,tbA,tbB,GL,P0,P1); \
    KRD(GL,1); GAPB(o[1]=__builtin_amdgcn_mfma_f32_32x32x16_bf16(PAF(1),VFR(5),o[1],0,0,0), C0,12, 3,tbB,tbA,GL,P0,P1); \
    KRD(GL,2); GAPB(o[0]=__builtin_amdgcn_mfma_f32_32x32x16_bf16(PAF(2),VFR(2),o[0],0,0,0), C1,0, 4,tbA,tbB,GL,P0,P1); \
    KRD(GL,3); GAPB(o[1]=__builtin_amdgcn_mfma_f32_32x32x16_bf16(PAF(2),VFR(6),o[1],0,0,0), C1,4, 5,tbB,tbA,GL,P0,P1); \
    GAPB(o[0]=__builtin_amdgcn_mfma_f32_32x32x16_bf16(PAF(3),VFR(3),o[0],0,0,0), C1,8, 6,tbA,tbB,GL,P0,P1); \
    GAPB(o[1]=__builtin_amdgcn_mfma_f32_32x32x16_bf16(PAF(3),VFR(7),o[1],0,0,0), C1,12, 7,tbB,tbA,GL,P0,P1); \
    }while(0)
  int t=1;
  for(;t+5<NT;t+=2){
    STEP(pB0,pB1,pA0,pA1,t,true,true,true);     WAIT_BAR(2); RESC(); ROT();
    STEP(pA0,pA1,pB0,pB1,t+1,true,true,true);   WAIT_BAR(2); RESC(); ROT();
  }
  #define ENDW(tt) do{ if((tt)+3<NT){WAIT_BAR(2);} else if((tt)+2<NT){WAIT_BAR(1);} else {WAIT_BAR(0);} }while(0)
  for(;t+1<NT;t+=2){
    STEP(pB0,pB1,pA0,pA1,t,(t+3<NT),(t+1<NT),(t+1<NT));       ENDW(t);   RESC(); ROT();
    STEP(pA0,pA1,pB0,pB1,t+1,(t+4<NT),(t+2<NT),(t+2<NT));     ENDW(t+1); RESC(); ROT();
  }
  STEP(pB0,pB1,pA0,pA1,NT-1,false,false,false); RESC();
  { float sacc=pB0[0]+pB0[1]; _Pragma("unroll") for(int r=2;r<16;++r)sacc+=pB0[r]; _Pragma("unroll") for(int r=0;r<16;++r)sacc+=pB1[r]; l_reg+=sacc;
    pw0=(u32x4){PKW(pB0,0),PKW(pB0,2),PKW(pB0,4),PKW(pB0,6)};pw1=(u32x4){PKW(pB0,8),PKW(pB0,10),PKW(pB0,12),PKW(pB0,14)};pw2=(u32x4){PKW(pB1,0),PKW(pB1,2),PKW(pB1,4),PKW(pB1,6)};pw3=(u32x4){PKW(pB1,8),PKW(pB1,10),PKW(pB1,12),PKW(pB1,14)};
    SBAR(); pv(o,vb0+sl_cur,PAF(0),PAF(1),PAF(2),PAF(3)); }
  #undef PKW
  #undef PAF
  #undef VFR
  #undef PIN
  #undef MX3
  #undef GAPA
  #undef GAPB
  #undef EX
  #undef VRD
  #undef KRD
  #undef STEP
  #undef ENDW
  {auto rr=__builtin_amdgcn_permlane32_swap(__float_as_uint(l_reg),__float_as_uint(l_reg),false,false);l_reg=__uint_as_float(rr[0])+__uint_as_float(rr[1]);}
  if(hi==0)wsf[32+r32]=l_reg;asm volatile("s_waitcnt lgkmcnt(0)":::"memory");
  float rli[16];
  #pragma unroll
  for(int r=0;r<16;++r)rli[r]=__builtin_amdgcn_rcpf(wsf[32+crow(r,hi)]);
  bf16*Ow=O+(rowbase+q0+wid*QBLK)*DM+h*D;
  { bf16*stg=(bf16*)(shm+LDS_OST)+wid*2048;
    #pragma unroll
    for(int r=0;r<16;++r){const int orow=crow(r,hi);
      #pragma unroll
      for(int d0=0;d0<2;++d0)stg[orow*64+d0*32+r32]=__float2bfloat16(o[d0][r]*rli[r]);}
    asm volatile("s_waitcnt lgkmcnt(0)":::"memory");
    #pragma unroll
    for(int i=0;i<4;++i){const int row=i*8+(lane>>3),ch=lane&7; const u32x4 v=*(const u32x4*)(stg+row*64+ch*8); ATTN_STORE16(Ow+(long)row*DM+ch*8,v);} }
  asm volatile("s_waitcnt lgkmcnt(0)\n\ts_barrier":::"memory");
  #undef DMA_K
  #undef DMA_V
  #undef CMASK
  #undef DECIDE
  #undef BIAS
  #undef RESC
  #undef ROT
}
constexpr int ATTN_LDS_BYTES=LDS_BYTES;
template<int THRL=8> __device__ __forceinline__ void attn_phase(char*lds,int vcu,int G,const bf16*Q,const bf16*K,const bf16*V,bf16*O,const float*logf){
  for(int v=vcu;v<BATCH*NHEAD*2;v+=G){ const int bh=v>>1,s_=v&1;
    {
      typedef __attribute__((address_space(3))) float* lds_fptr; typedef __attribute__((address_space(3))) f32x4v* lds_f4ptr;
      char*shm=lds; const int tid=threadIdx.x,lane=tid&63; const int wid=__builtin_amdgcn_readfirstlane(tid>>6); const int h=bh%NHEAD; const long rowbase=(long)(bh/NHEAD)*SEQ;
      const lds_fptr cb3=(lds_fptr)(shm+LDS_CB); const lds_fptr sc3=(lds_fptr)(shm+LDS_SC);
      asm volatile("s_waitcnt lgkmcnt(0)\n\ts_barrier":::"memory");
      float v0=logf[(rowbase+4*tid+0)*NHEAD+h],v1=logf[(rowbase+4*tid+1)*NHEAD+h],v2=logf[(rowbase+4*tid+2)*NHEAD+h],v3=logf[(rowbase+4*tid+3)*NHEAD+h];
      v1+=v0;v2+=v1;v3+=v2; float x=v3;
      #pragma unroll
      for(int off=1;off<64;off<<=1){const float n_=__shfl_up(x,off); if(lane>=off)x+=n_;}
      if(lane==63)sc3[wid]=x;
      asm volatile("s_waitcnt lgkmcnt(0)\n\ts_barrier":::"memory");
      float pre=x-v3; for(int w2=0;w2<wid;++w2)pre+=sc3[w2];
      const float L2E=1.4426950408889634f;
      *(lds_f4ptr)(cb3+4*tid)=(f32x4v){(pre+v0)*L2E,(pre+v1)*L2E,(pre+v2)*L2E,(pre+v3)*L2E};
      asm volatile("s_waitcnt lgkmcnt(0)\n\ts_barrier":::"memory"); }
    #pragma unroll 1
    for(int i=0;i<4;++i){ const int qb=s_?(i==0?2:i==1?5:i==2?3:4):(i==0?0:i==1?7:i==2?1:6);
      attn_unit<THRL>(bh/NHEAD,bh%NHEAD,qb,Q,K,V,O,logf,lds); } }
}
#undef SBAR
#undef WAIT_BAR
}

constexpr int NWAVES = 8;
constexpr int BATCH = 8, SEQ = 2048, D = 1024, NH = 16, NE = 16, FE = 512, M = BATCH * SEQ;
constexpr int SLOTS = 2 * M + NE * 256;
constexpr float RMS_EPS = 1e-6f;
constexpr size_t MiB = 1u << 20;
constexpr size_t WS_CTL = 0, CTL_ZERO_BYTES = 64 * 1024;
constexpr size_t WS_RSTD = 1 * MiB;
constexpr size_t WS_ROUTE = 2 * MiB;
constexpr size_t WS_LOGF = 3 * MiB;
constexpr size_t WS_WQKV = 8 * MiB, WS_WOA = 14 * MiB, WS_WKVQ = 16 * MiB, WS_WOB = 22 * MiB;
constexpr size_t WS_WGU = 24 * MiB;
constexpr size_t WS_WD = 88 * MiB;
constexpr size_t WS_Q = 120 * MiB, WS_K = 152 * MiB, WS_V = 184 * MiB, WS_XB = 216 * MiB;
constexpr size_t WS_Y = 120 * MiB;
constexpr size_t WS_HS = 248 * MiB;
constexpr size_t WS_HQ = 266 * MiB;
constexpr size_t WS_ROWTAB = 4 * MiB;
constexpr size_t WS_END = 284 * MiB;
static_assert(WS_Y + (size_t)SLOTS * D * 2 <= WS_XB && WS_HS + (size_t)SLOTS * FE * 2 <= WS_END, "ws map");
constexpr int CW_CNT = 64;
constexpr int CW_BAR = 4096;
constexpr int ROWIDX_OFF = 131072, RSTAB_OFF = 131072 + 3072;
constexpr int RING_BYTES = 131072, LDSCTL_OFF = 139264, MISC_OFF = LDSCTL_OFF + 320, LDS_BYTES = 147456;
constexpr int NPH = 17;

#define GAS __attribute__((address_space(1)))
#define LAS __attribute__((address_space(3)))
typedef unsigned short bf16;
typedef unsigned v4u __attribute__((ext_vector_type(4)));
typedef float f32x4 __attribute__((ext_vector_type(4)));
typedef short bf16x8 __attribute__((ext_vector_type(8)));
typedef GAS unsigned gu32;
typedef GAS unsigned long long gu64;
#define RLX_AGENT __ATOMIC_RELAXED, __HIP_MEMORY_SCOPE_AGENT
#define LDS_WAIT() asm volatile("s_waitcnt lgkmcnt(0)" ::: "memory")
#define VM_WAIT() asm volatile("s_waitcnt vmcnt(0)" ::: "memory")
__device__ __forceinline__ unsigned long long rt() { return __builtin_amdgcn_s_memrealtime(); }
__device__ __forceinline__ unsigned f2bf(float f) { unsigned u = __builtin_bit_cast(unsigned, f); return (u + 0x7fffu + ((u >> 16) & 1u)) >> 16; }
__device__ __forceinline__ unsigned pk2(float lo, float hi) { return f2bf(lo) | (f2bf(hi) << 16); }

#define XB_TMO      128
#define XB_XCNT(j)  (256  + 64 * (j))
#define XB_XSUB(j)  (1280 + 64 * (j))
#define XB_XGEN(j)  (2304 + 64 * (j))
#define XB_TOP      3328
#define XB_TOPGEN   3392
#define XCD_BAR_WORDS 3456
#define XB_XLOC(j)  (3456 + 64 * (j))
#define XB_XMAP(r)  (4480 + (r))
#define XB_SPIN_CAP (1u << 18)

__device__ __forceinline__ unsigned xb_ld(unsigned* p)              { return __hip_atomic_load(p, __ATOMIC_RELAXED, __HIP_MEMORY_SCOPE_AGENT); }
__device__ __forceinline__ unsigned xb_add(unsigned* p, unsigned v) { return __hip_atomic_fetch_add(p, v, __ATOMIC_RELAXED, __HIP_MEMORY_SCOPE_AGENT); }
__device__ __forceinline__ unsigned xb_xcc_id() { return (unsigned)__builtin_amdgcn_s_getreg((3 << 11) | 20) & 0xFu; }
#define XB_SPIN(cond, bar) do { unsigned _sp = 0; while (cond) { __builtin_amdgcn_s_sleep(1); \
    if ((++_sp & 255u) == 0u) { if (xb_ld(&(bar)[XB_TMO])) break; if (_sp > XB_SPIN_CAP) { atomicAdd(&(bar)[XB_TMO], 1u); break; } } } } while (0)

struct XcdBarrier {
    unsigned* bar; unsigned x;
    volatile LAS unsigned* st;
};

__device__ __forceinline__ XcdBarrier xcd_barrier_post(unsigned* bar, volatile LAS unsigned* st) {
    XcdBarrier b; b.bar = bar; b.x = xb_xcc_id(); b.st = st;
    if (threadIdx.x == 0) (void)xb_add(&bar[XB_XCNT(b.x)], 1u);
    return b;
}
__device__ __forceinline__ void xcd_barrier_complete(unsigned* bar, unsigned x, unsigned& nloc, unsigned& nx) {
    const unsigned G = gridDim.x * gridDim.y * gridDim.z;
    unsigned sum, cnt, mine, sp = 0u;
    for (;;) {
        sum = 0u; cnt = 0u; mine = 0u;
#pragma unroll
        for (unsigned j = 0; j < 16; ++j) { const unsigned c = xb_ld(&bar[XB_XCNT(j)]); sum += c; cnt += (c > 0u) ? 1u : 0u; mine = (j == x) ? c : mine; }
        if (sum == G) break;
        __builtin_amdgcn_s_sleep(1);
        if ((++sp & 255u) == 0u) { if (xb_ld(&bar[XB_TMO])) break; if (sp > XB_SPIN_CAP) { atomicAdd(&bar[XB_TMO], 1u); break; } }
    }
    nloc = mine > 0u ? mine : 1u; nx = cnt > 0u ? cnt : 1u;
}

struct NoShadow { __device__ __forceinline__ void operator()() const {} };
template <bool LOCAL = false, class Shadow = NoShadow>
__device__ __forceinline__ void xcd_barrier(const XcdBarrier& b, const Shadow& shadow = Shadow()) {
    asm volatile("s_waitcnt vmcnt(0)" ::: "memory");
    __syncthreads();
    if (threadIdx.x >= 64) { shadow(); asm volatile("s_waitcnt vmcnt(0)" ::: "memory"); }
    if (threadIdx.x == 0) {
        unsigned* bar = b.bar;
        __builtin_amdgcn_s_waitcnt(0);
        unsigned nloc = b.st[0], nx = b.st[1];
        bool local = false;
        if constexpr (LOCAL) { unsigned mode = b.st[2];
            if (mode == 0u && nloc != 0u) { bool ok = (gridDim.x == 256u);
#pragma unroll
                for (unsigned r = 0; r < 8; ++r) { const unsigned m_ = xb_ld(&bar[XB_XMAP(r)]); ok = ok && (m_ != 0u) && ((m_ & (m_ - 1u)) == 0u); }
                mode = ok ? 1u : 2u; b.st[2] = mode; }
            local = (mode == 1u); }
        if (local) {
            const unsigned lgen = b.st[3]; b.st[3] = lgen + 1u;
            (void)__hip_atomic_fetch_add(&bar[XB_XLOC(b.x)], 1u, __ATOMIC_RELAXED, __HIP_MEMORY_SCOPE_AGENT);
            { const unsigned target = (lgen + 1u) * nloc; XB_SPIN(xb_ld(&bar[XB_XLOC(b.x)]) < target, bar); }
            __builtin_amdgcn_fence(__ATOMIC_ACQUIRE, "agent");
            asm volatile("s_waitcnt vmcnt(0)" ::: "memory");
        } else {
        if (nloc == 0u) { xcd_barrier_complete(bar, b.x, nloc, nx); b.st[0] = nloc; b.st[1] = nx; }
        const unsigned old = xb_add(&bar[XB_XSUB(b.x)], 1u);
        const unsigned gen = old / nloc;
        if (old + 1u == (gen + 1u) * nloc) {
            __builtin_amdgcn_fence(__ATOMIC_RELEASE, "agent");
            asm volatile("s_waitcnt vmcnt(0)" ::: "memory");
            (void)__hip_atomic_fetch_add(&bar[XB_TOP], 1u, __ATOMIC_RELAXED, __HIP_MEMORY_SCOPE_AGENT);
        }
        { const unsigned target = (gen + 1u) * nx; XB_SPIN(xb_ld(&bar[XB_TOP]) < target, bar); }
        __builtin_amdgcn_fence(__ATOMIC_ACQUIRE, "agent");
        asm volatile("s_waitcnt vmcnt(0)" ::: "memory");
        }
    }
    __syncthreads();
}

struct Frame {
    LAS unsigned char* lds; volatile LAS unsigned* MISC; gu32* ctl;
    int tid, lane, wave, vcu, G;
};
__device__ __forceinline__ float wave_sum(float v) {
#pragma unroll
    for (int o = 1; o < 64; o <<= 1) v += __shfl_xor(v, o);
    return v;
}
__device__ __forceinline__ unsigned ldu(const unsigned* p) { return __hip_atomic_load(p, __ATOMIC_RELAXED, __HIP_MEMORY_SCOPE_AGENT); }
__device__ __forceinline__ unsigned cvtpk2(float lo, float hi) { typedef float f2 __attribute__((ext_vector_type(2))); typedef __bf16 b2 __attribute__((ext_vector_type(2))); f2 v = {lo, hi}; b2 b = __builtin_convertvector(v, b2); return __builtin_bit_cast(unsigned, b); }
__device__ __forceinline__ float bflo(unsigned w) { return __uint_as_float(w << 16); }
__device__ __forceinline__ float bfhi(unsigned w) { return __uint_as_float(w & 0xffff0000u); }

struct TItem { const float* W; const float* gain; bf16* WT; int ldw, K, k0, n0, dst_row0; const float* dummy; float f8 = 0.f; };
__device__ __forceinline__ void titem_load(const TItem& t, int lane, f32x4 (&v)[16], float (&g)[16]) {
    const int kq = lane >> 4, c4 = (lane & 15) * 4;
#pragma unroll
    for (int i = 0; i < 16; ++i) { const int kk = 4 * i + kq; v[i] = __builtin_nontemporal_load((const GAS f32x4*)(t.W + (size_t)(t.k0 + kk) * t.ldw + t.n0 + c4)); { const float gl_ = (t.gain ? t.gain : t.dummy)[(t.k0 + kk) & 1023]; g[i] = t.gain ? gl_ : 1.f; } }
}
__device__ __forceinline__ void titem_store(const TItem& t, int lane, const f32x4 (&v)[16], const float (&g)[16], LAS float* scr) {
    const int kq = lane >> 4, c4 = (lane & 15) * 4;
#pragma unroll
    for (int i = 0; i < 16; ++i) { const int kk = 4 * i + kq; const f32x4 x = v[i] * g[i]; LAS float* s = scr + kk * 65 + c4; s[0] = x.x; s[1] = x.y; s[2] = x.z; s[3] = x.w; }
    LDS_WAIT(); asm volatile("" ::: "memory");
    const int c = 4 * (lane >> 5) + ((lane >> 3) & 3), nl = lane & 7;
#pragma unroll
    for (int j = 0; j < 8; ++j) { const int n = 8 * j + nl; const LAS float* s = scr + (8 * c) * 65 + n;
        if (t.f8 != 0.f) { typedef unsigned u2_ __attribute__((ext_vector_type(2))); u2_ o; o.x = pg8::pk4_fp8(s[0], s[65], s[2 * 65], s[3 * 65], t.f8); o.y = pg8::pk4_fp8(s[4 * 65], s[5 * 65], s[6 * 65], s[7 * 65], t.f8);
            *(GAS u2_*)((unsigned char*)t.WT + (size_t)(t.dst_row0 + n) * t.K + t.k0 + 8 * c) = o; }
        else { v4u o; o.x = cvtpk2(s[0], s[65]); o.y = cvtpk2(s[2 * 65], s[3 * 65]); o.z = cvtpk2(s[4 * 65], s[5 * 65]); o.w = cvtpk2(s[6 * 65], s[7 * 65]);
            *(GAS v4u*)(t.WT + (size_t)(t.dst_row0 + n) * t.K + t.k0 + 8 * c) = o; } }
    LDS_WAIT(); asm volatile("" ::: "memory");
}
__device__ __forceinline__ void titem32_load(const TItem& t, int lane, f32x4 (&v)[8], float (&g)[8]) {
    const int rq = lane >> 3, c4 = (lane & 7) * 4;
#pragma unroll
    for (int i = 0; i < 8; ++i) { const int kk = 8 * i + rq; v[i] = __builtin_nontemporal_load((const GAS f32x4*)(t.W + (size_t)(t.k0 + kk) * t.ldw + t.n0 + c4)); { const float gl_ = (t.gain ? t.gain : t.dummy)[(t.k0 + kk) & 1023]; g[i] = t.gain ? gl_ : 1.f; } }
}
__device__ __forceinline__ void titem32_store(const TItem& t, int lane, const f32x4 (&v)[8], const float (&g)[8], LAS float* scr) {
    const int rq = lane >> 3, c4 = (lane & 7) * 4;
#pragma unroll
    for (int i = 0; i < 8; ++i) { const int kk = 8 * i + rq; const f32x4 x = v[i] * g[i]; LAS float* s = scr + kk * 33 + c4; s[0] = x.x; s[1] = x.y; s[2] = x.z; s[3] = x.w; }
    LDS_WAIT(); asm volatile("" ::: "memory");
    const int c = 4 * (lane >> 5) + ((lane >> 3) & 3), nl = lane & 7;
#pragma unroll
    for (int j = 0; j < 4; ++j) { const int n = 8 * j + nl; const LAS float* s = scr + (8 * c) * 33 + n;
        if (t.f8 != 0.f) { typedef unsigned u2_ __attribute__((ext_vector_type(2))); u2_ o; o.x = pg8::pk4_fp8(s[0], s[33], s[2 * 33], s[3 * 33], t.f8); o.y = pg8::pk4_fp8(s[4 * 33], s[5 * 33], s[6 * 33], s[7 * 33], t.f8);
            *(GAS u2_*)((unsigned char*)t.WT + (size_t)(t.dst_row0 + n) * t.K + t.k0 + 8 * c) = o; }
        else { v4u o; o.x = cvtpk2(s[0], s[33]); o.y = cvtpk2(s[2 * 33], s[3 * 33]); o.z = cvtpk2(s[4 * 33], s[5 * 33]); o.w = cvtpk2(s[6 * 33], s[7 * 33]);
            *(GAS v4u*)(t.WT + (size_t)(t.dst_row0 + n) * t.K + t.k0 + 8 * c) = o; } }
    LDS_WAIT(); asm volatile("" ::: "memory");
}
struct In {
    const float *x, *attn_norm, *w_qkv_a, *w_o_a, *kv_norm, *w_kvf, *b_f, *w_q_b, *w_o_b, *moe_norm, *w_group, *w_router, *w_gate, *w_up, *w_down, *final_norm;
};
__device__ __forceinline__ void p0_prologue(Frame& F, const In& I, unsigned char* ws) {
    int tid_ = threadIdx.x; asm volatile("" : "+v"(tid_));
    const int lane = tid_ & 63, wave = __builtin_amdgcn_readfirstlane(tid_ >> 6);
    LAS float* scr = (LAS float*)(F.lds + wave * 16640);
    const int gw = F.vcu * NWAVES + wave, NGW = F.G * NWAVES;
    bf16* Wqkv = (bf16*)(ws + WS_WQKV); bf16* Woa = (bf16*)(ws + WS_WOA); bf16* Wkvq = (bf16*)(ws + WS_WKVQ); bf16* Wob = (bf16*)(ws + WS_WOB);
    bf16* Wgu = (bf16*)(ws + WS_WGU); bf16* Wd = (bf16*)(ws + WS_WD);
    constexpr int NITEMS = 16 * 48;
    auto decode = [&](int r) -> TItem { return TItem{I.w_qkv_a, I.attn_norm, Wqkv, 3072, 1024, 64 * (r / 48), 64 * (r % 48), 64 * (r % 48), I.attn_norm}; };
    {
        f32x4 nv[16]; float ng[16]; int it = gw; TItem cur{};
        if (it < NITEMS) { cur = decode(it); titem_load(cur, lane, nv, ng); }
        for (; it < NITEMS; it += NGW) {
            f32x4 v[16]; float g[16];
#pragma unroll
            for (int i = 0; i < 16; ++i) { v[i] = nv[i]; g[i] = ng[i]; }
            const TItem me = cur;
            if (it + NGW < NITEMS) { cur = decode(it + NGW); titem_load(cur, lane, nv, ng); }
            titem_store(me, lane, v, g, scr);
        }
    }
    for (int r = (gw + NGW - (NITEMS % NGW)) % NGW; r < 16 * 32; r += NGW) {
        const TItem t{I.w_o_a, nullptr, Woa, 1024, 1024, 64 * (r / 32), 32 * (r % 32), 32 * (r % 32), I.attn_norm};
        f32x4 v[8]; float g[8]; titem32_load(t, lane, v, g); titem32_store(t, lane, v, g, scr); }
    bf16* XB = (bf16*)(ws + WS_XB); float* rstd = (float*)(ws + WS_RSTD);
    {
        f32x4 na[4], nb[4]; int m = gw;
#define P0_LD(dst, m_) do { const GAS f32x4* xr_ = (const GAS f32x4*)(I.x + (size_t)((m_) < M ? (m_) : gw) * D) + lane; _Pragma("unroll") for (int j = 0; j < 4; ++j) dst[j] = __builtin_nontemporal_load(xr_ + 64 * j); } while (0)
#define P0_ST(v, m_) do { if ((m_) < M) { float s_ = 0.f; _Pragma("unroll") for (int j = 0; j < 4; ++j) s_ += (v[j].x * v[j].x + v[j].y * v[j].y) + (v[j].z * v[j].z + v[j].w * v[j].w); \
            s_ = wave_sum(s_); \
            _Pragma("unroll") for (int jp = 0; jp < 2; ++jp) {     \
                const unsigned a0_ = cvtpk2(v[2 * jp].x, v[2 * jp].y), a1_ = cvtpk2(v[2 * jp].z, v[2 * jp].w), b0_ = cvtpk2(v[2 * jp + 1].x, v[2 * jp + 1].y), b1_ = cvtpk2(v[2 * jp + 1].z, v[2 * jp + 1].w); \
                const unsigned na0_ = (unsigned)__builtin_amdgcn_mov_dpp((int)a0_, 0xB1, 0xF, 0xF, true), na1_ = (unsigned)__builtin_amdgcn_mov_dpp((int)a1_, 0xB1, 0xF, 0xF, true), \
                               nb0_ = (unsigned)__builtin_amdgcn_mov_dpp((int)b0_, 0xB1, 0xF, 0xF, true), nb1_ = (unsigned)__builtin_amdgcn_mov_dpp((int)b1_, 0xB1, 0xF, 0xF, true); \
                const bool od_ = lane & 1; v4u o_; o_.x = od_ ? nb0_ : a0_; o_.y = od_ ? nb1_ : a1_; o_.z = od_ ? b0_ : na0_; o_.w = od_ ? b1_ : na1_; \
                *(GAS v4u*)(XB + (size_t)(m_) * D + 256 * (2 * jp + (od_ ? 1 : 0)) + 4 * (lane & ~1)) = o_; } \
            if (lane == 0) rstd[m_] = 1.f / sqrtf(s_ * (1.f / D) + RMS_EPS); } } while (0)
        P0_LD(na, m); P0_LD(nb, m + NGW);
        for (; m < M; m += 2 * NGW) {
            f32x4 va[4], vb[4];
#pragma unroll
            for (int j = 0; j < 4; ++j) { va[j] = na[j]; vb[j] = nb[j]; }
            P0_LD(na, m + 2 * NGW); P0_LD(nb, m + 3 * NGW);
            P0_ST(va, m); P0_ST(vb, m + NGW);
        }
#undef P0_LD
#undef P0_ST
    }
}

__device__ __forceinline__ TItem dense_item(const In& I, unsigned char* ws, int r) {
    bf16* Woa = (bf16*)(ws + WS_WOA); bf16* Wkvq = (bf16*)(ws + WS_WKVQ); bf16* Wob = (bf16*)(ws + WS_WOB);
    constexpr int J_SQ = 16 * 32, J_KV = 16 * 64;
    if (r < J_SQ) return TItem{I.w_o_a, nullptr, Woa, 1024, 1024, 64 * (r / 32), 32 * (r % 32), 32 * (r % 32), I.attn_norm}; r -= J_SQ;
    if (r < J_KV) return TItem{I.w_kvf, I.kv_norm, Wkvq, 2064, 1024, 64 * (r / 64), 32 * (r % 64), 32 * (r % 64), I.attn_norm, pg8::F8_SW}; r -= J_KV;
    if (r < J_SQ) return TItem{I.w_q_b, I.attn_norm + 1024, Wkvq, 1024, 1024, 64 * (r / 32), 32 * (r % 32), 2048 + 32 * (r % 32), I.attn_norm, pg8::F8_SW}; r -= J_SQ;
    return TItem{I.w_o_b, nullptr, Wob, 1024, 1024, 64 * (r / 32), 32 * (r % 32), 32 * (r % 32), I.attn_norm};
}
__device__ __forceinline__ TItem expert_item(const In& I, unsigned char* ws, int l, int r) {
    bf16* Wgu = (bf16*)(ws + WS_WGU); bf16* Wd = (bf16*)(ws + WS_WD);
    const int kind = r >> 12, q = r & 4095, le = l * 16 + (q >> 8), q2 = q & 255;
    if (kind < 2) { const int kb = q2 >> 4, nb = q2 & 15, f0 = 32 * nb;
        return TItem{(kind ? I.w_up : I.w_gate) + (size_t)le * 1024 * 512, I.moe_norm + l * 1024, (bf16*)((unsigned char*)Wgu + (size_t)l * 16 * 1024 * 1024 * 2 + (size_t)(q >> 8) * 1024 * 1024), 512, 1024, 64 * kb, f0, 256 * (f0 >> 7) + 128 * kind + (f0 & 127), I.attn_norm, pg8::F8_SW}; }
    { const int kb = q2 >> 5, nb = q2 & 31;
      return TItem{I.w_down + (size_t)le * 512 * 1024, nullptr, (bf16*)((unsigned char*)Wd + (size_t)le * 1024 * 512), 1024, 512, 64 * kb, 32 * nb, 32 * nb, I.attn_norm, pg8::F8_SW}; }
}
constexpr int DENSE_ITEMS = 3 * 16 * 32 + 16 * 64, DENSE_L0 = 16 * 32, EXPERT_ITEMS = 3 * 16 * 256;
constexpr int DEFERRED_ITEMS = 0;
constexpr int TAIL_DN0 = 16 * 256 - 7 * 256;
constexpr int TAIL_ITEMS = TAIL_DN0 + EXPERT_ITEMS + (DENSE_ITEMS - DENSE_L0);
constexpr int SHADOW_PER_BAR = 7 * 256, SHADOW_GU = 4 * SHADOW_PER_BAR, SHADOW_DN = SHADOW_PER_BAR, SHADOW_ITEMS = 5 * SHADOW_PER_BAR;
constexpr int GU_ITEMS = 2 * 16 * 256, DN_ITEMS = 16 * 256;
__device__ __forceinline__ TItem shadow_decode(const In& I, unsigned char* ws, int r) {
    if (r < SHADOW_GU) return expert_item(I, ws, 0, r); r -= SHADOW_GU; return expert_item(I, ws, 0, GU_ITEMS + r); }
__device__ __forceinline__ TItem deferred_decode(const In& I, unsigned char* ws, int r) { return expert_item(I, ws, 0, GU_ITEMS + SHADOW_DN + r); }
constexpr int ROUTER_IDLE_ITEMS = 2 * 16 * 256 - 4 * 7 * 256;
__device__ __forceinline__ TItem tail_decode(const In& I, unsigned char* ws, int r) {
    if (r < TAIL_DN0) return expert_item(I, ws, 0, 2 * 16 * 256 + 7 * 256 + r); r -= TAIL_DN0;
    if (r < DENSE_ITEMS - DENSE_L0) return dense_item(I, ws, DENSE_L0 + r); return expert_item(I, ws, 1, r - (DENSE_ITEMS - DENSE_L0)); }
constexpr int TAIL_G3 = 3 * 1792, TAIL_G4 = TAIL_G3 + 2 * 1792;
__device__ __forceinline__ void tail_items(const In& I, unsigned char* ws, int slot, int nslots, int lo, int hi, LAS float* scr) {
    int lane_ = threadIdx.x & 63; asm volatile("" : "+v"(lane_)); const int lane = lane_;
    f32x4 nv[8]; float ng[8]; TItem cur{}; int it = lo + slot;
    if (it < hi) { cur = tail_decode(I, ws, it); titem32_load(cur, lane, nv, ng); }
    for (; it < hi; it += nslots) {
        f32x4 v[8]; float g[8];
#pragma unroll
        for (int i = 0; i < 8; ++i) { v[i] = nv[i]; g[i] = ng[i]; }
        const TItem me = cur;
        if (it + nslots < hi) { cur = tail_decode(I, ws, it + nslots); titem32_load(cur, lane, nv, ng); }
        titem32_store(me, lane, v, g, scr);
    }
}
__device__ __forceinline__ void deferred_items(const In& I, unsigned char* ws, int gw, int NGW, int round, LAS float* scr) {
    int lane_ = threadIdx.x & 63; asm volatile("" : "+v"(lane_)); const int lane = lane_;
    const int jmax = (DEFERRED_ITEMS + NGW - 1) / NGW;
    int j = 4 * round; const int jend = (round == 3) ? jmax : (4 * round + 4 < jmax ? 4 * round + 4 : jmax);
    f32x4 nv[8]; float ng[8]; TItem cur{};
    if (j < jend && gw + NGW * j < DEFERRED_ITEMS) { cur = deferred_decode(I, ws, gw + NGW * j); titem32_load(cur, lane, nv, ng); }
    for (; j < jend && gw + NGW * j < DEFERRED_ITEMS; ++j) {
        f32x4 v[8]; float g[8];
#pragma unroll
        for (int i = 0; i < 8; ++i) { v[i] = nv[i]; g[i] = ng[i]; }
        const TItem me = cur;
        if (j + 1 < jend && gw + NGW * (j + 1) < DEFERRED_ITEMS) { cur = deferred_decode(I, ws, gw + NGW * (j + 1)); titem32_load(cur, lane, nv, ng); }
        titem32_store(me, lane, v, g, scr);
    }
}

typedef float f32x16 __attribute__((ext_vector_type(16)));
typedef unsigned u32x4v __attribute__((ext_vector_type(4)));
constexpr int DOT_STRIDE = 36, DOT_TILE_BYTES = 64 * DOT_STRIDE * 4, RED_STRIDE = 33;
typedef short bfx8 __attribute__((ext_vector_type(8)));
__device__ __forceinline__ void split2(float x0, float x1, unsigned& hi, unsigned& lo) {
    hi = cvtpk2(x0, x1); lo = cvtpk2(x0 - __uint_as_float(hi << 16), x1 - __uint_as_float(hi & 0xffff0000u));
}
template <bool A_BF16 = false>
__device__ __forceinline__ void rowdots_chunk_mfma(const LAS float* tile, int lane, const u32x4v (&bh)[2], const u32x4v (&bl)[2], f32x16 (&acc)[2], float (&ss)[2]) {
#pragma unroll
    for (int rb = 0; rb < 2; ++rb)
#pragma unroll
        for (int st = 0; st < 2; ++st) { const LAS f32x4* ap = (const LAS f32x4*)(tile + (32 * rb + (lane & 31)) * DOT_STRIDE + 16 * st + 8 * (lane >> 5));
            const f32x4 a0 = ap[0], a1 = ap[1];
            ss[rb] += (a0.x * a0.x + a0.y * a0.y) + (a0.z * a0.z + a0.w * a0.w) + (a1.x * a1.x + a1.y * a1.y) + (a1.z * a1.z + a1.w * a1.w);
            u32x4v ah, al; { unsigned h_, l_; split2(a0.x, a0.y, h_, l_); ah.x = h_; al.x = l_; } { unsigned h_, l_; split2(a0.z, a0.w, h_, l_); ah.y = h_; al.y = l_; } { unsigned h_, l_; split2(a1.x, a1.y, h_, l_); ah.z = h_; al.z = l_; } { unsigned h_, l_; split2(a1.z, a1.w, h_, l_); ah.w = h_; al.w = l_; }
            const bfx8 Ah = __builtin_bit_cast(bfx8, ah), Al = __builtin_bit_cast(bfx8, al), Bh = __builtin_bit_cast(bfx8, bh[st]), Bl = __builtin_bit_cast(bfx8, bl[st]);
            acc[rb] = __builtin_amdgcn_mfma_f32_32x32x16_bf16(Ah, Bh, acc[rb], 0, 0, 0);
            acc[rb] = __builtin_amdgcn_mfma_f32_32x32x16_bf16(Ah, Bl, acc[rb], 0, 0, 0);
            if (!A_BF16) acc[rb] = __builtin_amdgcn_mfma_f32_32x32x16_bf16(Al, Bh, acc[rb], 0, 0, 0); }
}
__device__ __forceinline__ void rowdots_publish(LAS float* red, LAS float* sst, int wave, int lane, const f32x16 (&acc)[2], const float (&ss)[2]) {
#pragma unroll
    for (int rb = 0; rb < 2; ++rb) {
#pragma unroll
        for (int r = 0; r < 16; ++r) red[(wave * 64 + 32 * rb + (r & 3) + 8 * (r >> 2) + 4 * (lane >> 5)) * RED_STRIDE + (lane & 31)] = acc[rb][r];
        sst[wave * 128 + rb * 64 + lane] = ss[rb]; }
}
template <int NC>
__device__ __forceinline__ void rowdots_collect(const LAS float* red, const LAS float* sst, int lane, float (&a)[NC], float& ssum) {
#pragma unroll
    for (int n = 0; n < NC; ++n) { float s = 0.f;
#pragma unroll
        for (int w = 0; w < 8; ++w) s += red[(w * 64 + lane) * RED_STRIDE + n]; a[n] = s; }
    float s = 0.f;
#pragma unroll
    for (int w = 0; w < 8; ++w) s += sst[w * 128 + (lane >> 5) * 64 + (lane & 31)] + sst[w * 128 + (lane >> 5) * 64 + 32 + (lane & 31)];
    ssum = s;
}
__device__ __forceinline__ void slot_bases(Frame& F, const unsigned* cnt, LAS int* sb) {
    if (F.tid < 64) {
        const int c = F.tid < 16 ? (int)ldu(cnt + F.tid) : 0, p = ((c + 255) >> 8) << 8; int x = p;
#pragma unroll
        for (int off = 1; off < 16; off <<= 1) { const int n = __shfl_up(x, off); if (F.tid >= off) x += n; }
        if (F.tid < 16) { sb[F.tid] = x - p; ((LAS int*)(F.lds + RSTAB_OFF + 3072))[F.tid] = c; }
        if (F.tid == 15) sb[16] = x; }
    __syncthreads();
}

template <class Idle>
__device__ __forceinline__ void router_phase(Frame& F, const bf16* h, const float* gain, const float* wg, const float* wr, unsigned* cnt, unsigned* route, int* rowtab, const Idle& idle) {
    int tid_ = threadIdx.x; asm volatile("" : "+v"(tid_));
    const int lane = tid_ & 63, wave = __builtin_amdgcn_readfirstlane(tid_ >> 6);
    LAS float* tile = (LAS float*)(F.lds + wave * DOT_TILE_BYTES);
    LAS float* red = (LAS float*)F.lds;
    LAS float* sst = (LAS float*)(F.lds + 8 * 64 * RED_STRIDE * 4);
    u32x4v bh[4][2], bl[4][2];
    { const int col = lane & 31, hi = lane >> 5;
#pragma unroll
      for (int ch = 0; ch < 4; ++ch)
#pragma unroll
          for (int st = 0; st < 2; ++st) { float w[8];
#pragma unroll
              for (int j = 0; j < 8; ++j) { const int k = wave * 128 + ch * 32 + st * 16 + hi * 8 + j;
                  const float* src = col < 4 ? wg + k * 4 + col : wr + k * 16 + (col < 20 ? col - 4 : 0);
                  w[j] = *src * gain[k] * (col < 20 ? 1.f : 0.f); }
              { unsigned h_, l_; split2(w[0], w[1], h_, l_); bh[ch][st].x = h_; bl[ch][st].x = l_; } { unsigned h_, l_; split2(w[2], w[3], h_, l_); bh[ch][st].y = h_; bl[ch][st].y = l_; } { unsigned h_, l_; split2(w[4], w[5], h_, l_); bh[ch][st].z = h_; bl[ch][st].z = l_; } { unsigned h_, l_; split2(w[6], w[7], h_, l_); bh[ch][st].w = h_; bl[ch][st].w = l_; } } }
    for (int rb = F.vcu; rb < M / 64; rb += F.G) {
        const int r0 = rb * 64; float ss[2] = {0.f, 0.f}; f32x16 acc[2]; acc[0] = f32x16{}; acc[1] = f32x16{};
        const int row_l = lane >> 3, c4 = (lane & 7) * 4;
        unsigned long long pre[8];
#pragma unroll
        for (int i = 0; i < 8; ++i) pre[i] = *(const GAS unsigned long long*)(h + (size_t)(r0 + row_l + 8 * i) * D + wave * 128 + c4);
#pragma unroll
        for (int ch = 0; ch < 4; ++ch) { const int k0 = wave * 128 + ch * 32;
#pragma unroll
            for (int i = 0; i < 8; ++i) { const int row = row_l + 8 * i; const unsigned pl = (unsigned)pre[i], ph = (unsigned)(pre[i] >> 32); *(LAS f32x4*)(tile + row * DOT_STRIDE + c4) = (f32x4){bflo(pl), bfhi(pl), bflo(ph), bfhi(ph)}; }
            if (ch < 3) {
#pragma unroll
                for (int i = 0; i < 8; ++i) pre[i] = *(const GAS unsigned long long*)(h + (size_t)(r0 + row_l + 8 * i) * D + k0 + 32 + c4); }
            LDS_WAIT(); asm volatile("" ::: "memory");
            rowdots_chunk_mfma<true>(tile, lane, bh[ch], bl[ch], acc, ss);
            LDS_WAIT(); asm volatile("" ::: "memory");
        }
        __syncthreads();
        rowdots_publish(red, sst, wave, lane, acc, ss);
        __syncthreads();
        LAS float* fin = (LAS float*)(F.lds + 8 * 64 * RED_STRIDE * 4 + 4096 + 7 * 8448);
#pragma unroll
        for (int q3 = 0; q3 < 3; ++q3) { const int n = wave + 8 * q3; if (n < 20) { float s_ = 0.f;
#pragma unroll
                for (int w = 0; w < 8; ++w) s_ += red[(w * 64 + lane) * RED_STRIDE + n]; fin[n * 64 + lane] = s_; }
            else if (n == 20) { float s_ = 0.f;
#pragma unroll
                for (int w = 0; w < 8; ++w) s_ += sst[w * 128 + (lane >> 5) * 64 + (lane & 31)] + sst[w * 128 + (lane >> 5) * 64 + 32 + (lane & 31)]; fin[20 * 64 + lane] = s_; } }
        __syncthreads();
        if (wave == 0) {
            float a[20]; float ssum;
#pragma unroll
            for (int n = 0; n < 20; ++n) a[n] = fin[n * 64 + lane];
            ssum = fin[20 * 64 + lane];
            const float rstd = 1.f / sqrtf(ssum * (1.f / D) + RMS_EPS);
            float lg[4];
#pragma unroll
            for (int g = 0; g < 4; ++g) lg[g] = a[g] * rstd;
            int gi = 0; float best = lg[0];
#pragma unroll
            for (int g = 1; g < 4; ++g) if (lg[g] > best) { best = lg[g]; gi = g; }
            float den = 0.f;
#pragma unroll
            for (int g = 0; g < 4; ++g) den += __expf(lg[g] - best);
            const float gprob = 1.f / den;
            float le[4];
#pragma unroll
            for (int j = 0; j < 4; ++j) le[j] = rstd * (gi == 0 ? a[4 + j] : gi == 1 ? a[8 + j] : gi == 2 ? a[12 + j] : a[16 + j]);
            int i0 = 0; float t0 = le[0];
#pragma unroll
            for (int j = 1; j < 4; ++j) if (le[j] > t0) { t0 = le[j]; i0 = j; }
            int i1 = -1; float t1 = -INFINITY;
#pragma unroll
            for (int j = 0; j < 4; ++j) if (j != i0 && le[j] > t1) { t1 = le[j]; i1 = j; }
            const float ex = __expf(t1 - t0), w0 = gprob / (1.f + ex), w1 = gprob * ex / (1.f + ex);
            const int e0 = gi * 4 + i0, e1 = gi * 4 + i1;
            int mycount = 0, p0 = 0, p1 = 0; const unsigned long long lt = (1ull << lane) - 1ull;
#pragma unroll
            for (int e = 0; e < 16; ++e) { const unsigned long long mk = __ballot(e0 == e || e1 == e); const int c = __popcll(mk), before = __popcll(mk & lt);
                if (lane == e) mycount = c; if (e0 == e) p0 = before; if (e1 == e) p1 = before; }
            unsigned basev = 0;
            if (lane < 16) basev = __hip_atomic_fetch_add(cnt + lane, (unsigned)mycount, __ATOMIC_RELAXED, __HIP_MEMORY_SCOPE_AGENT);
            const unsigned b0 = __shfl(basev, e0), b1 = __shfl(basev, e1);
            unsigned* rt = route + (size_t)(r0 + lane) * 8;
            v4u q; q.x = (unsigned)e0 | ((unsigned)e1 << 8); q.y = b0 + (unsigned)p0; q.z = b1 + (unsigned)p1; q.w = __float_as_uint(w0);
            *(v4u*)rt = q; rt[4] = __float_as_uint(w1); rt[5] = __float_as_uint(rstd);
            { att::u32x2 te_; te_.x = (unsigned)(r0 + lane); te_.y = __float_as_uint(rstd); ((att::u32x2*)rowtab)[e0 * M + (int)q.y] = te_; ((att::u32x2*)rowtab)[e1 * M + (int)q.z] = te_; }
        } else { idle(rb); }
        __syncthreads();
    }
}
__device__ __forceinline__ void combine_prep_phase(Frame& F, const bf16* h, const bf16* Y, const unsigned* cnt, const unsigned* route, const float* kvg, const float* wkvf, const float* bf_, bf16* hout, float* rstd_out, float* logf) {
    int tid_ = threadIdx.x; asm volatile("" : "+v"(tid_));
    const int lane = tid_ & 63, wave = __builtin_amdgcn_readfirstlane(tid_ >> 6);
    LAS int* sb = (LAS int*)(F.lds + LDSCTL_OFF + 64);
    slot_bases(F, cnt, sb);
    LAS float* tile = (LAS float*)(F.lds + wave * DOT_TILE_BYTES);
    LAS float* red = (LAS float*)F.lds;
    LAS float* sst = (LAS float*)(F.lds + 8 * 64 * RED_STRIDE * 4);
    const int bcol = lane & 15, bhi = lane >> 5; const float bmask = (lane & 31) < 16 ? 1.f : 0.f;
    for (int rb = F.vcu; rb < M / 64; rb += F.G) {
        const int r0 = rb * 64; float ss[2] = {0.f, 0.f}; f32x16 acc[2]; acc[0] = f32x16{}; acc[1] = f32x16{};
        const int row_l = lane >> 2, c8 = (lane & 3) * 8;
        int s0[4], s1[4]; float w0[4], w1[4];
#pragma unroll
        for (int i = 0; i < 4; ++i) { const size_t m = (size_t)(r0 + row_l + 16 * i); const v4u q = *(const GAS v4u*)(route + m * 8); w0[i] = __uint_as_float(q.w); w1[i] = __uint_as_float(ldu(route + m * 8 + 4));
            s0[i] = sb[q.x & 255] + (int)q.y; s1[i] = sb[(q.x >> 8) & 255] + (int)q.z; }
#pragma unroll 1
        for (int ch = 0; ch < 4; ++ch) { const int k0 = wave * 128 + ch * 32;
            u32x4v bh[2], bl[2];
#pragma unroll
            for (int st = 0; st < 2; ++st) { float w[8];
#pragma unroll
                for (int j = 0; j < 8; ++j) { const int k = k0 + st * 16 + bhi * 8 + j; w[j] = wkvf[(size_t)k * 2064 + 2048 + bcol] * kvg[k] * bmask; }
                { unsigned h_, l_; split2(w[0], w[1], h_, l_); bh[st].x = h_; bl[st].x = l_; } { unsigned h_, l_; split2(w[2], w[3], h_, l_); bh[st].y = h_; bl[st].y = l_; } { unsigned h_, l_; split2(w[4], w[5], h_, l_); bh[st].z = h_; bl[st].z = l_; } { unsigned h_, l_; split2(w[6], w[7], h_, l_); bh[st].w = h_; bl[st].w = l_; } }
            v4u ph_[4], py0[4], py1[4];
#pragma unroll
            for (int i = 0; i < 4; ++i) { ph_[i] = *(const GAS v4u*)(h + (size_t)(r0 + row_l + 16 * i) * D + k0 + c8);
                py0[i] = *(const GAS v4u*)(Y + (size_t)s0[i] * D + k0 + c8); py1[i] = *(const GAS v4u*)(Y + (size_t)s1[i] * D + k0 + c8); }
#pragma unroll
            for (int i = 0; i < 4; ++i) { const int row = row_l + 16 * i; const size_t m = (size_t)(r0 + row); float v[8];
                const unsigned hw[4] = {ph_[i].x, ph_[i].y, ph_[i].z, ph_[i].w}, a0[4] = {py0[i].x, py0[i].y, py0[i].z, py0[i].w}, a1[4] = {py1[i].x, py1[i].y, py1[i].z, py1[i].w};
#pragma unroll
                for (int j = 0; j < 4; ++j) { v[2 * j] = bflo(hw[j]) + w0[i] * bflo(a0[j]) + w1[i] * bflo(a1[j]); v[2 * j + 1] = bfhi(hw[j]) + w0[i] * bfhi(a0[j]) + w1[i] * bfhi(a1[j]); }
                v4u o; o.x = cvtpk2(v[0], v[1]); o.y = cvtpk2(v[2], v[3]); o.z = cvtpk2(v[4], v[5]); o.w = cvtpk2(v[6], v[7]);
                *(GAS v4u*)(hout + m * D + k0 + c8) = o;
                *(LAS f32x4*)(tile + row * DOT_STRIDE + c8) = (f32x4){v[0], v[1], v[2], v[3]}; *(LAS f32x4*)(tile + row * DOT_STRIDE + c8 + 4) = (f32x4){v[4], v[5], v[6], v[7]}; }
            LDS_WAIT(); asm volatile("" ::: "memory");
            rowdots_chunk_mfma(tile, lane, bh, bl, acc, ss);
            LDS_WAIT(); asm volatile("" ::: "memory");
        }
        __syncthreads();
        rowdots_publish(red, sst, wave, lane, acc, ss);
        __syncthreads();
        if (wave == 0) {
            float a[16]; float ssum; rowdots_collect<16>(red, sst, lane, a, ssum);
            const float rstd = 1.f / sqrtf(ssum * (1.f / D) + RMS_EPS);
            rstd_out[r0 + lane] = rstd;
            float lf[16];
#pragma unroll
            for (int n = 0; n < 16; ++n) { const float xg = a[n] * rstd + bf_[n]; lf[n] = fminf(xg, 0.f) - log1pf(__expf(-fabsf(xg))); }
            GAS f32x4* lo = (GAS f32x4*)(logf + (size_t)(r0 + lane) * 16);
#pragma unroll
            for (int j = 0; j < 4; ++j) lo[j] = (f32x4){lf[4 * j], lf[4 * j + 1], lf[4 * j + 2], lf[4 * j + 3]};
        }
        __syncthreads();
    }
}
__device__ __forceinline__ void combine_prep_rows(Frame& F, const bf16* h, const bf16* Y, const unsigned* cnt, const unsigned* route, const float* kvg, const float* wkvf, const float* bf_, bf16* hout, float* rstd_out, float* logf, unsigned char* hq8) {
    int tid_ = threadIdx.x; asm volatile("" : "+v"(tid_));
    const int tid = tid_, lane = tid & 63, wave = __builtin_amdgcn_readfirstlane(tid >> 6);
    LAS int* sb = (LAS int*)(F.lds + LDSCTL_OFF + 64);
    slot_bases(F, cnt, sb);
    constexpr int TAB = 32768, ZOFF = 2 * TAB, TILE0 = ZOFF + 64, TSTRIDE = 68, TSZ = 9 * TSTRIDE * 4 + 256;
    LAS v4u* tabH = (LAS v4u*)F.lds; LAS v4u* tabL = (LAS v4u*)(F.lds + TAB);
#pragma unroll 1
    for (int i = 0; i < 4; ++i) { const int e = tid + 512 * i, s_ = e >> 5, hi_ = (e >> 4) & 1, col = e & 15; float w[8];
#pragma unroll
        for (int j = 0; j < 8; ++j) { const int k = 16 * s_ + 8 * hi_ + j; w[j] = wkvf[(size_t)k * 2064 + 2048 + col] * kvg[k]; }
        v4u H, L; { unsigned h_, l_; split2(w[0], w[1], h_, l_); H.x = h_; L.x = l_; } { unsigned h_, l_; split2(w[2], w[3], h_, l_); H.y = h_; L.y = l_; }
        { unsigned h_, l_; split2(w[4], w[5], h_, l_); H.z = h_; L.z = l_; } { unsigned h_, l_; split2(w[6], w[7], h_, l_); H.w = h_; L.w = l_; }
        tabH[e] = H; tabL[e] = L; }
    LAS float* tile = (LAS float*)(F.lds + TILE0 + wave * TSZ); LAS float* ssc = tile + 9 * TSTRIDE;
    if (tid < 16) ((LAS unsigned*)(F.lds + ZOFF))[tid] = 0u;
    for (int c = lane; c < TSTRIDE; c += 64) tile[8 * TSTRIDE + c] = 0.f;
    __syncthreads();
    const int srow = lane >> 3, c8 = (lane & 7) * 8;
    const int ar = lane & 31, ahi = lane >> 5, arow = ar < 8 ? ar : 8;
    const int bidx0 = ar < 16 ? ahi * 16 + ar : -1;
    for (int g = F.vcu * NWAVES + wave; g < M / 8; g += F.G * NWAVES) {
        const int R = g * 8; const size_t m = (size_t)(R + srow);
        const v4u q = *(const GAS v4u*)(route + m * 8); const float w0 = __uint_as_float(q.w) * (1.f / pg8::F8_SY), w1 = __uint_as_float(ldu(route + m * 8 + 4)) * (1.f / pg8::F8_SY);
        const int s0 = sb[q.x & 255] + (int)q.y, s1 = sb[(q.x >> 8) & 255] + (int)q.z;
        const bf16* hp = h + m * D + c8; const unsigned char* y0p = (const unsigned char*)Y + (size_t)s0 * D + c8; const unsigned char* y1p = (const unsigned char*)Y + (size_t)s1 * D + c8; bf16* op = hout + m * D + c8; unsigned char* oq = hq8 + m * D + c8;
        f32x16 acc = f32x16{}; float ss = 0.f; unsigned hqx = 0u, hqy = 0u;
        typedef unsigned v2u_ __attribute__((ext_vector_type(2))); typedef float f2_ __attribute__((ext_vector_type(2)));
        v4u lhA, lhB, lhC; v2u_ l0A, l1A, l0B, l1B, l0C, l1C;
#define C1R_LOAD(S_, c_) do { lh##S_ = *(const GAS v4u*)(hp + 64 * (c_)); l0##S_ = *(const GAS v2u_*)(y0p + 64 * (c_)); l1##S_ = *(const GAS v2u_*)(y1p + 64 * (c_)); } while (0)
#define C1R_PROC(S_, c_) do { const v4u qh = lh##S_; const v2u_ a0 = l0##S_, a1 = l1##S_; float v[8]; \
            const unsigned hw[4] = {qh.x, qh.y, qh.z, qh.w}, y0w[2] = {a0.x, a0.y}, y1w[2] = {a1.x, a1.y}; \
            _Pragma("unroll") for (int j = 0; j < 4; ++j) { const f2_ e0 = (j & 1) ? __builtin_amdgcn_cvt_pk_f32_fp8(y0w[j >> 1], true) : __builtin_amdgcn_cvt_pk_f32_fp8(y0w[j >> 1], false), \
                e1 = (j & 1) ? __builtin_amdgcn_cvt_pk_f32_fp8(y1w[j >> 1], true) : __builtin_amdgcn_cvt_pk_f32_fp8(y1w[j >> 1], false); \
                v[2 * j] = bflo(hw[j]) + w0 * e0.x + w1 * e1.x; v[2 * j + 1] = bfhi(hw[j]) + w0 * e0.y + w1 * e1.y; } \
            v4u o; o.x = cvtpk2(v[0], v[1]); o.y = cvtpk2(v[2], v[3]); o.z = cvtpk2(v[4], v[5]); o.w = cvtpk2(v[6], v[7]); \
            *(GAS v4u*)(op + 64 * (c_)) = o; \
            { const unsigned x8_ = pg8::pk4_fp8(v[0], v[1], v[2], v[3], pg8::F8_SA), y8_ = pg8::pk4_fp8(v[4], v[5], v[6], v[7], pg8::F8_SA);     \
              if (((c_) & 1) == 0) { hqx = x8_; hqy = y8_; } \
              else { const bool od_ = lane & 1; const unsigned nax_ = (unsigned)__builtin_amdgcn_mov_dpp((int)hqx, 0xB1, 0xF, 0xF, true), nay_ = (unsigned)__builtin_amdgcn_mov_dpp((int)hqy, 0xB1, 0xF, 0xF, true), \
                         nbx_ = (unsigned)__builtin_amdgcn_mov_dpp((int)x8_, 0xB1, 0xF, 0xF, true), nby_ = (unsigned)__builtin_amdgcn_mov_dpp((int)y8_, 0xB1, 0xF, 0xF, true); \
                     v4u o16; o16.x = od_ ? nbx_ : hqx; o16.y = od_ ? nby_ : hqy; o16.z = od_ ? x8_ : nax_; o16.w = od_ ? y8_ : nay_; \
                     *(GAS v4u*)(oq + 64 * ((c_) - (od_ ? 0 : 1)) - (od_ ? 8 : 0)) = o16; } } \
            *(LAS f32x4*)(tile + srow * TSTRIDE + c8) = (f32x4){v[0], v[1], v[2], v[3]}; *(LAS f32x4*)(tile + srow * TSTRIDE + c8 + 4) = (f32x4){v[4], v[5], v[6], v[7]}; \
            LDS_WAIT(); asm volatile("" ::: "memory"); \
            _Pragma("unroll") for (int st = 0; st < 4; ++st) { const LAS f32x4* ap = (const LAS f32x4*)(tile + arow * TSTRIDE + 16 * st + 8 * ahi); const f32x4 x0 = ap[0], x1 = ap[1]; \
                ss += (x0.x * x0.x + x0.y * x0.y) + (x0.z * x0.z + x0.w * x0.w) + (x1.x * x1.x + x1.y * x1.y) + (x1.z * x1.z + x1.w * x1.w); \
                u32x4v ah, al; { unsigned h_, l_; split2(x0.x, x0.y, h_, l_); ah.x = h_; al.x = l_; } { unsigned h_, l_; split2(x0.z, x0.w, h_, l_); ah.y = h_; al.y = l_; } \
                { unsigned h_, l_; split2(x1.x, x1.y, h_, l_); ah.z = h_; al.z = l_; } { unsigned h_, l_; split2(x1.z, x1.w, h_, l_); ah.w = h_; al.w = l_; } \
                const int be = bidx0 < 0 ? (ZOFF / 16) : bidx0 + (4 * (c_) + st) * 32; \
                const v4u bhv = tabH[be], blv = bidx0 < 0 ? tabH[be] : tabL[be]; \
                const bfx8 Ah = __builtin_bit_cast(bfx8, ah), Al = __builtin_bit_cast(bfx8, al), Bh = __builtin_bit_cast(bfx8, bhv), Bl = __builtin_bit_cast(bfx8, blv); \
                acc = __builtin_amdgcn_mfma_f32_32x32x16_bf16(Ah, Bh, acc, 0, 0, 0); \
                acc = __builtin_amdgcn_mfma_f32_32x32x16_bf16(Ah, Bl, acc, 0, 0, 0); \
                acc = __builtin_amdgcn_mfma_f32_32x32x16_bf16(Al, Bh, acc, 0, 0, 0); } \
            LDS_WAIT(); asm volatile("" ::: "memory"); } while (0)
        C1R_LOAD(A, 0); C1R_LOAD(B, 1); C1R_LOAD(C, 2);
#pragma unroll 1
        for (int c = 0; c < 15; c += 3) {
            C1R_PROC(A, c); C1R_LOAD(A, c + 3);
            C1R_PROC(B, c + 1); if (c + 4 < 16) C1R_LOAD(B, c + 4);
            C1R_PROC(C, c + 2); if (c + 5 < 16) C1R_LOAD(C, c + 5);
        }
        C1R_PROC(A, 15);
#undef C1R_LOAD
#undef C1R_PROC
        ssc[lane] = ss; LDS_WAIT(); asm volatile("" ::: "memory");
        if (lane < 8) rstd_out[R + lane] = 1.f / sqrtf((ssc[lane] + ssc[lane + 32]) * (1.f / D) + RMS_EPS);
        if (ar < 16) { const float bfc = bf_[ar];
#pragma unroll
            for (int r = 0; r < 4; ++r) { const int row = 4 * ahi + r; const float rs = 1.f / sqrtf((ssc[row] + ssc[row + 32]) * (1.f / D) + RMS_EPS);
                const float xg = acc[r] * rs + bfc; logf[(size_t)(R + row) * 16 + ar] = fminf(xg, 0.f) - log1pf(__expf(-fabsf(xg))); } }
        LDS_WAIT(); asm volatile("" ::: "memory");
    }
}
__device__ __forceinline__ void final_phase(Frame& F, const bf16* h, float* out, const bf16* Y, const unsigned* cnt, const unsigned* route, const float* gain) {
    int tid_ = threadIdx.x; asm volatile("" : "+v"(tid_));
    const int lane = tid_ & 63, wave = __builtin_amdgcn_readfirstlane(tid_ >> 6);
    LAS int* sb = (LAS int*)(F.lds + LDSCTL_OFF + 64);
    slot_bases(F, cnt, sb);
    const int gw = F.vcu * NWAVES + wave, NGW = F.G * NWAVES;
    f32x4 gv[4];
#pragma unroll
    for (int j = 0; j < 4; ++j) gv[j] = *((const GAS f32x4*)gain + lane + 64 * j);
    unsigned long long nv[4]; unsigned ny0[4], ny1[4]; float nw0 = 0.f, nw1 = 0.f; unsigned rv2 = 0;
#define F_ROUTE(m_) (((m_) < M) ? route[(size_t)(m_) * 8 + (lane & 7)] : 0u)
#define F_LOAD(m_, rv_) do { const unsigned q0_ = __builtin_amdgcn_readlane(rv_, 0); \
        const int s0_ = sb[q0_ & 255] + (int)__builtin_amdgcn_readlane(rv_, 1), s1_ = sb[(q0_ >> 8) & 255] + (int)__builtin_amdgcn_readlane(rv_, 2); \
        nw0 = __uint_as_float(__builtin_amdgcn_readlane(rv_, 3)) * (1.f / pg8::F8_SY); nw1 = __uint_as_float(__builtin_amdgcn_readlane(rv_, 4)) * (1.f / pg8::F8_SY); \
        const GAS unsigned long long* xr_ = (const GAS unsigned long long*)(h + (size_t)(m_) * D) + lane; \
        const GAS unsigned* y0p_ = (const GAS unsigned*)((const unsigned char*)Y + (size_t)s0_ * D) + lane; const GAS unsigned* y1p_ = (const GAS unsigned*)((const unsigned char*)Y + (size_t)s1_ * D) + lane;     \
        _Pragma("unroll") for (int j = 0; j < 4; ++j) { nv[j] = xr_[64 * j]; ny0[j] = y0p_[64 * j]; ny1[j] = y1p_[64 * j]; } } while (0)
    int m = gw;
    if (m < M) { const unsigned rv0 = F_ROUTE(m); rv2 = F_ROUTE(m + NGW); F_LOAD(m, rv0); }
    for (; m < M; m += NGW) {
        f32x4 v[4]; unsigned y0[4], y1[4]; const float w0 = nw0, w1 = nw1;
#pragma unroll
        for (int j = 0; j < 4; ++j) { const unsigned pl = (unsigned)nv[j], ph = (unsigned)(nv[j] >> 32); v[j] = (f32x4){bflo(pl), bfhi(pl), bflo(ph), bfhi(ph)}; y0[j] = ny0[j]; y1[j] = ny1[j]; }
        const unsigned rv1 = rv2;
        if (m + NGW < M) { rv2 = F_ROUTE(m + 2 * NGW); F_LOAD(m + NGW, rv1); }
        float s = 0.f;
#pragma unroll
        for (int j = 0; j < 4; ++j) { typedef float f2_ __attribute__((ext_vector_type(2)));
            const f2_ a0 = __builtin_amdgcn_cvt_pk_f32_fp8(y0[j], false), a1 = __builtin_amdgcn_cvt_pk_f32_fp8(y0[j], true), b0 = __builtin_amdgcn_cvt_pk_f32_fp8(y1[j], false), b1 = __builtin_amdgcn_cvt_pk_f32_fp8(y1[j], true);
            v[j].x += w0 * a0.x + w1 * b0.x; v[j].y += w0 * a0.y + w1 * b0.y; v[j].z += w0 * a1.x + w1 * b1.x; v[j].w += w0 * a1.y + w1 * b1.y;
            s += (v[j].x * v[j].x + v[j].y * v[j].y) + (v[j].z * v[j].z + v[j].w * v[j].w); }
        const float rstd = 1.f / sqrtf(wave_sum(s) * (1.f / D) + RMS_EPS);
        GAS f32x4* xr = (GAS f32x4*)(out + (size_t)m * D) + lane;
#pragma unroll
        for (int j = 0; j < 4; ++j) __builtin_nontemporal_store(v[j] * gv[j] * rstd, xr + 64 * j);
    }
#undef F_ROUTE
#undef F_LOAD
}

template <bool GATEUP>
__device__ __forceinline__ void moe_mini(const Frame& F, const LAS int* pt, const LAS int* ecnt, int u_lo, int u_hi, const bf16* A, const bf16* Bt, bf16* Out, const int* rowtab, const unsigned* route) {
    constexpr int K = (GATEUP ? D : FE) / 2, NC = K / 64, NBUF = 5, BUFB = 24576;
    static_assert(NC >= NBUF - 1, "the prologue fills NBUF - 1 chunks");
    int lane_ = threadIdx.x & 63; asm volatile("" : "+v"(lane_)); const int lane = lane_, r32 = lane & 31, hi = lane >> 5, dkey = lane >> 3, dj = lane & 7;
    const int w = F.wave, tb = w & 3, wg = w >> 2;
    const LAS char* lp = (const LAS char*)F.lds;
    const unsigned l0 = (unsigned)__builtin_amdgcn_readfirstlane((unsigned)(size_t)lp);
    int koff[4];
#pragma unroll
    for (int d0 = 0; d0 < 4; ++d0) koff[d0] = r32 * 128 + (((2 * d0 + hi) ^ ((r32 >> 1) & 7)) * 16);
    const int woff = wg * 4096, toff = 8192 + tb * 4096;
    for (int ct = (int)blockIdx.x; ct < (u_hi - u_lo) * 8; ct += F.G) {
        const int wgid = u_lo + (ct >> 3), th = ct & 1, cg = (ct >> 1) & 3, rt = wgid >> 2, j = wgid & 3;
        int e = 0;
#pragma unroll
        for (int k = 1; k < 16; ++k) e += (pt[k] <= rt) ? 1 : 0;
        const int rowT = rt * 256 + th * 128, pos0 = (rt - pt[e]) * 256 + th * 128, last = GATEUP ? ecnt[e] - 1 : 0;
        const bf16* src[3]; unsigned dst[3]; float rs = 1.f;
#pragma unroll
        for (int i = 0; i < 3; ++i) { const int q = 3 * w + i;
            if (q < 8) { const int R = 8 * q + dkey, m = R & 31;
                const int wrow = e * 1024 + j * 256 + (GATEUP ? cg * 32 + (R >> 5) * 16 + (m & 15) + (m >> 4) * 128 : cg * 64 + R);
                src[i] = Bt + (size_t)wrow * K + (dj ^ ((R >> 1) & 7)) * 8; dst[i] = (unsigned)q * 1024u; }
            else { const int R = 8 * (q - 8) + dkey; size_t row;
                if constexpr (GATEUP) { const int pos = pos0 + R; row = (size_t)((const att::u32x2*)rowtab)[(size_t)e * M + (pos < last ? pos : last)].x; } else row = (size_t)(rowT + R);
                src[i] = A + row * K + (dj ^ ((R >> 1) & 7)) * 8; dst[i] = 8192u + (unsigned)(q - 8) * 1024u; } }
        if constexpr (GATEUP) { const int posr = pos0 + tb * 32 + r32; rs = __uint_as_float(((const att::u32x2*)rowtab)[(size_t)e * M + (posr < last ? posr : last)].y) * (1.f / (pg8::F8_SA * pg8::F8_SW)); }
#define MINI_DMA(c_, buf_) do { _Pragma("unroll") for (int i_ = 0; i_ < 3; ++i_) att::glds16(src[i_] + (c_) * 64, l0 + (unsigned)(buf_) * (unsigned)BUFB + dst[i_]); } while (0)
#pragma unroll
        for (int c = 0; c < NBUF - 1; ++c) MINI_DMA(c, c);
        att::f32x16 acc = att::f32x16{}; asm volatile("" : "+v"(acc));
        int bufc = 0, bufn = NBUF - 1;
        for (int c = 0; c < NC; ++c) {
            const int rem = NC - 1 - c;
            if (rem >= 3) asm volatile("s_waitcnt vmcnt(9)" ::: "memory"); else if (rem == 2) asm volatile("s_waitcnt vmcnt(6)" ::: "memory");
            else if (rem == 1) asm volatile("s_waitcnt vmcnt(3)" ::: "memory"); else asm volatile("s_waitcnt vmcnt(0)" ::: "memory");
            asm volatile("s_barrier" ::: "memory");
            if (c + NBUF - 1 < NC) MINI_DMA(c + NBUF - 1, bufn);
            const LAS char* b = lp + bufc * BUFB;
            att::bf16x8 wf[4], tf[4];
#pragma unroll
            for (int d0 = 0; d0 < 4; ++d0) { wf[d0] = *(const LAS att::bf16x8*)(b + woff + koff[d0]); tf[d0] = *(const LAS att::bf16x8*)(b + toff + koff[d0]); }
            asm volatile("s_waitcnt lgkmcnt(0)" ::: "memory");
            acc = __builtin_amdgcn_mfma_scale_f32_32x32x64_f8f6f4(pg8::cat8(wf[0], wf[1]), pg8::cat8(tf[0], tf[1]), acc, 0, 0, 0, 0, 0, 0);
            acc = __builtin_amdgcn_mfma_scale_f32_32x32x64_f8f6f4(pg8::cat8(wf[2], wf[3]), pg8::cat8(tf[2], tf[3]), acc, 0, 0, 0, 0, 0, 0);
            bufc = bufc + 1 == NBUF ? 0 : bufc + 1; bufn = bufn + 1 == NBUF ? 0 : bufn + 1;
        }
#undef MINI_DMA
        if constexpr (GATEUP) {
            unsigned char* op = (unsigned char*)Out + (size_t)(rowT + tb * 32 + r32) * FE + j * 128 + cg * 32 + wg * 16 + 4 * hi;
#pragma unroll
            for (int q = 0; q < 2; ++q) { float hv[4];
#pragma unroll
                for (int jj = 0; jj < 4; ++jj) { const float g = acc[4 * q + jj] * rs, up = acc[8 + 4 * q + jj] * rs;
                    hv[jj] = g * __builtin_amdgcn_rcpf(1.f + __builtin_amdgcn_exp2f(-1.4426950408889634f * g)) * up; }
                *(unsigned*)(op + 8 * q) = pg8::pk4_fp8(hv[0], hv[1], hv[2], hv[3], pg8::F8_SH); }
        } else {
            unsigned char* op = (unsigned char*)Out + (size_t)(rowT + tb * 32 + r32) * D + j * 256 + cg * 64 + wg * 32 + 4 * hi;
#pragma unroll
            for (int q = 0; q < 4; ++q) { constexpr float sc = pg8::F8_SY / (pg8::F8_SH * pg8::F8_SW); *(unsigned*)(op + 8 * q) = pg8::pk4_fp8(acc[4 * q], acc[4 * q + 1], acc[4 * q + 2], acc[4 * q + 3], sc); }
        }
        asm volatile("s_waitcnt vmcnt(0)" ::: "memory");
        __syncthreads();
    }
}

struct Args { const float* in[16]; float* out; unsigned char* ws; int ph_lo, ph_hi; };
__global__ void __launch_bounds__(NWAVES * 64, 2) fwd_kernel(Args args) {
    extern __shared__ __attribute__((aligned(16))) unsigned char lds[];
    Frame F;
    F.lds = (LAS unsigned char*)lds;
    F.MISC = (volatile LAS unsigned*)(F.lds + MISC_OFF);
    F.tid = threadIdx.x; F.lane = F.tid & 63; F.wave = __builtin_amdgcn_readfirstlane(F.tid >> 6);
    F.G = gridDim.x; { const int bx = blockIdx.x; F.vcu = (F.G % 8 == 0) ? (bx % 8) * (F.G / 8) + bx / 8 : bx; }
    unsigned char* ws = args.ws;
    F.ctl = (gu32*)(ws + WS_CTL);
    In I; I.x = args.in[0]; I.attn_norm = args.in[1]; I.w_qkv_a = args.in[2]; I.w_o_a = args.in[3]; I.kv_norm = args.in[4]; I.w_kvf = args.in[5]; I.b_f = args.in[6]; I.w_q_b = args.in[7];
    I.w_o_b = args.in[8]; I.moe_norm = args.in[9]; I.w_group = args.in[10]; I.w_router = args.in[11]; I.w_gate = args.in[12]; I.w_up = args.in[13]; I.w_down = args.in[14]; I.final_norm = args.in[15];
    bf16* HB0 = (bf16*)args.out;
    bf16* HB1 = (bf16*)(ws + WS_WGU);
    bf16* Wqkv = (bf16*)(ws + WS_WQKV); bf16* Woa = (bf16*)(ws + WS_WOA); bf16* Wkvq = (bf16*)(ws + WS_WKVQ); bf16* Wob = (bf16*)(ws + WS_WOB);
    bf16* Wgu = (bf16*)(ws + WS_WGU); bf16* Wd = (bf16*)(ws + WS_WD);
    bf16* Qb = (bf16*)(ws + WS_Q); bf16* Kb = (bf16*)(ws + WS_K); bf16* Vb = (bf16*)(ws + WS_V); bf16* XB = (bf16*)(ws + WS_XB);
    bf16* Hs = (bf16*)(ws + WS_HS); bf16* Yb = (bf16*)(ws + WS_Y); int* rowtab = (int*)(ws + WS_ROWTAB);
    float* rstd = (float*)(ws + WS_RSTD); unsigned* route = (unsigned*)(ws + WS_ROUTE); float* logf = (float*)(ws + WS_LOGF);
    unsigned* cntw = (unsigned*)(ws + WS_CTL) + CW_CNT;
    for (int u = F.tid; u < (LDS_BYTES - LDSCTL_OFF) / 4; u += NWAVES * 64) ((LAS unsigned*)(F.lds + LDSCTL_OFF))[u] = 0u;
    __syncthreads();
    const int lo = args.ph_lo, hi = args.ph_hi;
    const bool multi = (hi - lo) > 1;
    XcdBarrier bar; bar.bar = (unsigned*)(F.ctl + CW_BAR); bar.x = 0; bar.st = nullptr;
    if (multi) { bar = xcd_barrier_post((unsigned*)(F.ctl + CW_BAR), F.MISC + 8); if (threadIdx.x == 0) (void)__hip_atomic_fetch_or(&bar.bar[XB_XMAP(blockIdx.x & 7u)], 1u << bar.x, __ATOMIC_RELAXED, __HIP_MEMORY_SCOPE_AGENT); }
#ifndef PHMASK
#define PHMASK 0x1ffffu
#endif
#define IN(k) (((PHMASK >> (k)) & 1u) && lo <= (k) && (k) < hi)
#define SHADOW_ITEM(decode_, it_) do { int lane_ = threadIdx.x & 63; asm volatile("" : "+v"(lane_)); f32x4 v_[8]; float g_[8]; const TItem t_ = decode_(I, ws, it_); \
        titem32_load(t_, lane_, v_, g_); titem32_store(t_, lane_, v_, g_, (LAS float*)(F.lds + F.wave * 16384)); } while (0)
#define SEAM_LOCAL(k) (((k) >= 1 && (k) <= 3) || ((k) >= 8 && (k) <= 11))
#define SEAM(k) do { if (IN(k) && IN((k) + 1)) { const int sl_ = (int)blockIdx.x * 7 + (F.wave - 1); \
        if ((k) < 5 && F.G == 256) { const int it_ = (k) * SHADOW_PER_BAR + sl_; xcd_barrier<SEAM_LOCAL(k)>(bar, [&]() { SHADOW_ITEM(shadow_decode, it_); }); } \
        else if ((k) >= 6 && (k) <= 10 && F.G == 256) { const int it_ = TAIL_G4 + ((k) - 6) * SHADOW_PER_BAR + sl_; xcd_barrier<SEAM_LOCAL(k)>(bar, [&]() { if (it_ < TAIL_ITEMS) SHADOW_ITEM(tail_decode, it_); }); }        \
        else xcd_barrier<SEAM_LOCAL(k)>(bar); } } while (0)
    LAS unsigned char* ring = F.lds;
    LAS int* sbt = (LAS int*)(F.lds + LDSCTL_OFF + 64);

#ifndef REPEAT_PH
#define REPEAT_PH -1
#endif
#define PH(k, ...) do { if (IN(k)) { __VA_ARGS__ if (REPEAT_PH == (k)) { xcd_barrier(bar); __VA_ARGS__ } } SEAM(k); } while (0)
    PH(0, { p0_prologue(F, I, ws); });
    PH(1, {
        pg8::Gemm g{XB, Wqkv, M, 3072, D}; pg8::StaticOrder S; S.init(M, 3072, F.G, (int)blockIdx.x);
        pg8::EpiSplit3 E{Qb, (size_t)(WS_K - WS_Q) / 2, 0, rstd, 0, att::C2, 1.f};
        pg8::gemm_phase<pg8::EpiSplit3, pg8::StaticOrder, true, true>(ring, g, S, E); });
    PH(2, { const int gw_ = F.vcu * NWAVES + F.wave, ngw_ = F.G * NWAVES;
        att::sb_phase((ALAS char*)ring, F.vcu, F.G, Qb, Kb, Vb, Qb  , [&](int round, ALAS char* wl) { deferred_items(I, ws, gw_, ngw_, round, (LAS float*)wl); }); });
    PH(3, {
        pg8::Gemm g{Qb, Woa, M, D, D}; pg8::StaticOrder S; S.init(M, D, F.G, (int)blockIdx.x);
        pg8::EpiResidBf<true> E{XB, HB0, D, ws + WS_HQ};
        pg8::gemm_phase<pg8::EpiResidBf<true>, pg8::StaticOrder, true, true>(ring, g, S, E); });
    constexpr int TAIL_SPLIT = TAIL_G3;
#define MOE_TAIL(nwg_, lo_, hi_) do { const int r_ = (nwg_) % F.G; const bool all_ = (r_ == 0) || (F.G - r_ < F.G / 2); const int c_ = (int)blockIdx.x; \
        if (all_ || c_ >= r_) { const int ic_ = all_ ? c_ : c_ - r_, nid_ = all_ ? F.G : F.G - r_; \
            tail_items(I, ws, ic_ * NWAVES + F.wave, nid_ * NWAVES, lo_, hi_, (LAS float*)(F.lds + F.wave * 16384)); } } while (0)
    constexpr int MINI_MAX = 96;
#define MOE_LAYER(l, PBASE) do { \
        unsigned* cnt = cntw + 64 * (l); \
        PH(PBASE, { router_phase(F, (l) == 0 ? HB0 : HB1, I.moe_norm + (l) * D, I.w_group + (size_t)(l) * D * 4, I.w_router + (size_t)(l) * D * 16, cnt, route, rowtab, [&](int rb_) { const int it_ = rb_ * 7 + (F.wave - 1); if ((l) == 0 && it_ < ROUTER_IDLE_ITEMS) { int lane_ = threadIdx.x & 63; asm volatile("" : "+v"(lane_)); f32x4 v_[8]; float g_[8]; \
                const TItem t_ = expert_item(I, ws, 0, SHADOW_GU + it_); titem32_load(t_, lane_, v_, g_); titem32_store(t_, lane_, v_, g_, (LAS float*)(F.lds + 8 * 64 * RED_STRIDE * 4 + 4096 + (F.wave - 1) * 8448)); } }); }); \
        PH((PBASE) + 2, { \
            slot_bases(F, cnt, sbt); \
            if (F.tid < 17) sbt[32 + F.tid] = sbt[F.tid] >> 8; \
            __syncthreads(); \
            const int nu_ = (sbt[16] >> 8) * 4, lf_ = ((l) == 1 && nu_ % F.G <= MINI_MAX) ? nu_ % F.G : 0;        \
            pg8::MoeOrder S; S.pt = (const PG8_LAS int*)(sbt + 32); S.nwg = nu_ - lf_; S.G = F.G; S.c = (int)blockIdx.x; S.rowidx = (const PG8_LAS int*)(F.lds + ROWIDX_OFF); \
            { int idx_[2], tok_[2]; bool ok_[2], in_[2]; float rs_[2];        \
              _Pragma("unroll") for (int q_ = 0; q_ < 2; ++q_) { idx_[q_] = F.tid + 512 * q_; pg8::Unit u_; ok_[q_] = idx_[q_] < 768 && S.next(idx_[q_] >> 8, u_); \
                  const int e_ = ok_[q_] ? (u_.pb >> 2) : 0, pos_ = ok_[q_] ? (u_.pm - sbt[32 + e_]) * 256 + (idx_[q_] & 255) : 0; in_[q_] = ok_[q_] && pos_ < ((LAS int*)(F.lds + RSTAB_OFF + 3072))[e_]; \
                  const att::u32x2 te_ = ((const att::u32x2*)rowtab)[in_[q_] ? e_ * M + pos_ : 0]; tok_[q_] = (int)te_.x; rs_[q_] = __uint_as_float(te_.y); } \
              _Pragma("unroll") for (int q_ = 0; q_ < 2; ++q_) { tok_[q_] = in_[q_] ? tok_[q_] : 0; rs_[q_] = in_[q_] ? rs_[q_] * (1.f / (pg8::F8_SA * pg8::F8_SW)) : 0.f; }        \
              _Pragma("unroll") for (int q_ = 0; q_ < 2; ++q_) if (ok_[q_]) { ((LAS int*)(F.lds + ROWIDX_OFF))[idx_[q_]] = tok_[q_]; ((LAS float*)(F.lds + RSTAB_OFF))[idx_[q_]] = rs_[q_]; } } \
            __syncthreads(); \
            pg8::Gemm g{(const bf16*)(ws + WS_HQ), Wgu + (size_t)(l) * 16 * 1024 * 1024, M, 1024, D / 2};        \
            pg8::EpiGateUp E{Hs, (const PG8_LAS float*)(F.lds + RSTAB_OFF)}; \
            pg8::gemm_phase<pg8::EpiGateUp, pg8::MoeOrder, true, true, true, true>(ring, g, S, E); \
            if ((l) == 1 && lf_ > 0) moe_mini<true>(F, sbt + 32, (const LAS int*)(F.lds + RSTAB_OFF + 3072), nu_ - lf_, nu_, (const bf16*)(ws + WS_HQ), Wgu + (size_t)(l) * 16 * 1024 * 1024, Hs, rowtab, route); \
            if ((l) == 0) MOE_TAIL(S.nwg, 0, TAIL_SPLIT); }); \
        PH((PBASE) + 3, { \
            if (!IN((PBASE) + 2)) { slot_bases(F, cnt, sbt); if (F.tid < 17) sbt[32 + F.tid] = sbt[F.tid] >> 8; __syncthreads(); }     \
            const int nu_ = (sbt[16] >> 8) * 4, lf_ = ((l) == 1 && nu_ % F.G <= MINI_MAX) ? nu_ % F.G : 0; \
            pg8::MoeOrder S; S.pt = (const PG8_LAS int*)(sbt + 32); S.nwg = nu_ - lf_; S.G = F.G; S.c = (int)blockIdx.x; S.rowidx = nullptr; \
            pg8::Gemm g{Hs, Wd + (size_t)(l) * 16 * 1024 * (FE / 2), SLOTS, 1024, FE / 2};        \
            pg8::EpiBf16Plain E{Yb, D, pg8::F8_SY / (pg8::F8_SH * pg8::F8_SW)}; \
            pg8::gemm_phase<pg8::EpiBf16Plain, pg8::MoeOrder, true, true, false, true>(ring, g, S, E); \
            if ((l) == 1 && lf_ > 0) moe_mini<false>(F, sbt + 32, nullptr, nu_ - lf_, nu_, Hs, Wd + (size_t)(l) * 16 * 1024 * (FE / 2), Yb, nullptr, nullptr); \
            if ((l) == 0) MOE_TAIL(S.nwg, TAIL_SPLIT, TAIL_G4); }); \
    } while (0)
    MOE_LAYER(0, 4);
    PH(8, { combine_prep_rows(F, HB0, Yb, cntw, route, I.kv_norm, I.w_kvf, I.b_f, HB1, rstd, logf, ws + WS_HQ); });
    PH(9, {
        pg8::Gemm g{(const bf16*)(ws + WS_HQ), Wkvq, M, 3072, D / 2}; pg8::StaticOrder S; S.init(M, 3072, F.G, (int)blockIdx.x);
        pg8::EpiSplit3 E{Qb, (size_t)(WS_K - WS_Q) / 2, 1, rstd, 2, att::C2, 1.f / (pg8::F8_SA * pg8::F8_SW)};
        pg8::gemm_phase<pg8::EpiSplit3, pg8::StaticOrder, true, true, false, true>(ring, g, S, E); });
    PH(10, { fatt::attn_phase<8>((char*)lds, F.vcu, F.G, (const fatt::bf16*)Qb, (const fatt::bf16*)Kb, (const fatt::bf16*)Vb, (fatt::bf16*)Qb, logf); });
    PH(11, {
        pg8::Gemm g{Qb, Wob, M, D, D}; pg8::StaticOrder S; S.init(M, D, F.G, (int)blockIdx.x);
        pg8::EpiResidBf<true> E{HB1, HB1, D, ws + WS_HQ};
        pg8::gemm_phase<pg8::EpiResidBf<true>, pg8::StaticOrder, true, true>(ring, g, S, E); });
    MOE_LAYER(1, 12);
    PH(16, { final_phase(F, HB1, args.out, Yb, cntw + 64, route, I.final_norm); });
#undef IN
#undef SEAM
}

#ifndef N_LAUNCH_MODE
#define N_LAUNCH_MODE 1
#endif
extern "C" void kernel_launch(void* const* d_in, const int* in_sizes, int n_in, void* d_out, int out_size, void* d_ws, size_t ws_size, hipStream_t stream) {
    static int grid = 0;
    if (grid == 0) {
        if (n_in != 16 || out_size != M * D || ws_size < WS_END) { fprintf(stderr, "kernel_launch: unexpected shapes (n_in %d, out %d, ws %zu)\n", n_in, out_size, ws_size); grid = -1; return; }
        int dev = 0, cus = 0;
        if (hipGetDevice(&dev) != hipSuccess || hipDeviceGetAttribute(&cus, hipDeviceAttributeMultiprocessorCount, dev) != hipSuccess) { grid = -1; return; }
        if (hipFuncSetAttribute((const void*)fwd_kernel, hipFuncAttributeMaxDynamicSharedMemorySize, LDS_BYTES) != hipSuccess) { fprintf(stderr, "kernel_launch: hipFuncSetAttribute failed\n"); grid = -1; return; }
        int per_cu = 0;
        if (hipOccupancyMaxActiveBlocksPerMultiprocessor(&per_cu, (const void*)fwd_kernel, NWAVES * 64, LDS_BYTES) != hipSuccess || per_cu < 1) fprintf(stderr, "kernel_launch: occupancy query says %d\n", per_cu);
        (void)hipGetLastError();
        grid = cus;
    }
    if (grid < 0) return;
    (void)hipMemsetAsync((char*)d_ws + WS_CTL, 0, CTL_ZERO_BYTES, stream);
    Args a{};
    for (int i = 0; i < 16; ++i) a.in[i] = (const float*)d_in[i];
    a.out = (float*)d_out; a.ws = (unsigned char*)d_ws;
#if N_LAUNCH_MODE == 1
    a.ph_lo = 0; a.ph_hi = NPH;
    void* kargs[] = {&a};
    hipError_t e = hipLaunchCooperativeKernel((const void*)fwd_kernel, dim3(grid), dim3(NWAVES * 64), kargs, LDS_BYTES, stream);
    if (e != hipSuccess) fprintf(stderr, "kernel_launch: cooperative launch failed: %s (grid %d)\n", hipGetErrorString(e), grid);
#else
    for (int p = 0; p < NPH; ++p) { a.ph_lo = p; a.ph_hi = p + 1; hipLaunchKernelGGL(fwd_kernel, dim3(grid), dim3(NWAVES * 64), LDS_BYTES, stream, a); }
#endif
}
```
